# Optimizing an MI355X kernel written in HIP

```python
import math
import jax, jax.numpy as jnp
from jax import lax
import numpy as np

D_MODEL = 1024
BATCH = 2
SEQ = 8192
DEPTH = 2

N_MIXERS = 2
N_HEADS = 16
HEAD_DIM = 64
WIDTH = N_HEADS * HEAD_DIM
MOBA_BLOCK = 256
MOBA_TOPK = 3
Q_CHUNK = 64
DECAY_LORA = 64
AAA_LORA = 64
N_SHIFT_STREAMS = 6
NORM_EPS = 1e-6
LNX_EPS = 64e-5

kernel_name = "hybrid_moba_rwkv7_trunk"


def rms_norm(x, g):
    xf = x.astype(jnp.float32)
    y = xf * lax.rsqrt(jnp.mean(xf * xf, axis=-1, keepdims=True) + NORM_EPS)
    return (y * g.astype(jnp.float32)).astype(x.dtype)


def alibi_slopes(n):
    return jnp.asarray([2.0 ** (-8.0 * (i + 1) / n) for i in range(n)], dtype=jnp.float32)


def to_heads(t):
    b, s, _ = t.shape
    return t.reshape(b, s, N_HEADS, HEAD_DIM).transpose(0, 2, 1, 3)


def moba_attention(q, k, v):
    B, H, S, dh = q.shape
    nb = -(-S // MOBA_BLOCK)
    s_pad = nb * MOBA_BLOCK
    pad = ((0, 0), (0, 0), (0, s_pad - S), (0, 0))
    kp = jnp.pad(k, pad)
    vp = jnp.pad(v, pad)
    k_blocks = kp.reshape(B, H, nb, MOBA_BLOCK, dh)
    v_blocks = vp.reshape(B, H, nb, MOBA_BLOCK, dh)
    k_mean = jnp.mean(k_blocks.astype(jnp.float32), axis=3).astype(q.dtype)
    topk = min(MOBA_TOPK, nb)
    slopes = alibi_slopes(H)[None, :, None, None]
    scale = dh ** -0.5
    b_idx = jnp.arange(B)[:, None, None, None]
    h_idx = jnp.arange(H)[None, :, None, None]
    blk_pos = jnp.arange(MOBA_BLOCK)

    def chunk(c):
        t0 = c * Q_CHUNK
        own = t0 // MOBA_BLOCK
        q_c = lax.dynamic_slice_in_dim(q, t0, Q_CHUNK, axis=2)
        t_int = t0 + jnp.arange(Q_CHUNK)
        t_f = t_int.astype(jnp.float32)
        gate = jnp.einsum('bhqd,bhnd->bhqn', q_c, k_mean).astype(jnp.float32)
        gate = jnp.where(jnp.arange(nb) < own, gate, -jnp.inf)
        _, sel = lax.top_k(gate, topk)
        sel_valid = jnp.arange(topk) < own
        k_sel = k_blocks[b_idx, h_idx, sel]
        v_sel = v_blocks[b_idx, h_idx, sel]
        s_sel = jnp.einsum('bhqd,bhqjld->bhqjl', q_c, k_sel).astype(jnp.float32) * scale
        pos_sel = (sel[..., None] * MOBA_BLOCK + blk_pos).astype(jnp.float32)
        s_sel = s_sel - slopes[..., None] * (t_f[:, None, None] - pos_sel)
        s_sel = jnp.where(sel_valid[:, None], s_sel, -jnp.inf)
        s_sel = s_sel.reshape(B, H, Q_CHUNK, topk * MOBA_BLOCK)
        k_own = lax.dynamic_slice_in_dim(kp, own * MOBA_BLOCK, MOBA_BLOCK, axis=2)
        v_own = lax.dynamic_slice_in_dim(vp, own * MOBA_BLOCK, MOBA_BLOCK, axis=2)
        pos_own = own * MOBA_BLOCK + blk_pos
        s_own = jnp.einsum('bhqd,bhld->bhql', q_c, k_own).astype(jnp.float32) * scale
        s_own = s_own - slopes * (t_f[:, None] - pos_own.astype(jnp.float32)[None, :])
        s_own = jnp.where(pos_own[None, :] <= t_int[:, None], s_own, -jnp.inf)
        p = jax.nn.softmax(jnp.concatenate([s_sel, s_own], axis=-1), axis=-1)
        p_sel = p[..., :topk * MOBA_BLOCK].reshape(B, H, Q_CHUNK, topk, MOBA_BLOCK).astype(v.dtype)
        p_own = p[..., topk * MOBA_BLOCK:].astype(v.dtype)
        return (jnp.einsum('bhqjl,bhqjld->bhqd', p_sel, v_sel)
                + jnp.einsum('bhql,bhld->bhqd', p_own, v_own))

    out = lax.map(chunk, jnp.arange(S // Q_CHUNK))
    return out.transpose(1, 2, 0, 3, 4).reshape(B, H, S, dh)


def moba_layer(x, norm_g, w_in, w_out):
    B, S, _ = x.shape
    h = rms_norm(x, norm_g)
    proj = h @ w_in
    q, k, v, gate = jnp.split(proj, 4, axis=-1)
    o = moba_attention(to_heads(q), to_heads(k), to_heads(v))
    o = o.transpose(0, 2, 1, 3).reshape(B, S, WIDTH)
    return x + (o * jax.nn.silu(gate)) @ w_out


def rwkv7_scan(r, w, k, v, kk, a):
    B, S, H, dh = r.shape
    seq_first = lambda t: jnp.moveaxis(t, 1, 0)

    def step(state, inp):
        r_t, w_t, k_t, v_t, kk_t, a_t = inp
        sa = jnp.einsum('bhvk,bhk->bhv', state, -kk_t)
        state = (state * w_t[:, :, None, :]
                 + sa[..., None] * (kk_t * a_t)[:, :, None, :]
                 + v_t[..., None] * k_t[:, :, None, :])
        return state, jnp.einsum('bhvk,bhk->bhv', state, r_t)

    s0 = jnp.zeros((B, H, dh, dh), jnp.float32)
    _, y = lax.scan(step, s0, tuple(seq_first(t) for t in (r, w, k, v, kk, a)))
    return jnp.moveaxis(y, 0, 1)


def rwkv7_layer(x, norm_g, mix, w_in, w0, w1, w2, a0, a1, a2, k_k, k_a, r_k, lnx_g, lnx_b, w_out):
    B, S, _ = x.shape
    f32 = jnp.float32
    h = rms_norm(x, norm_g)
    h_prev = jnp.pad(h, ((0, 0), (1, 0), (0, 0)))[:, :-1]
    xx = h_prev - h
    xs = h[:, :, None, :] + xx[:, :, None, :] * mix
    proj = jnp.einsum('bsnd,ndw->bsnw', xs[:, :, :4], w_in)
    r, k, v, g = proj[:, :, 0], proj[:, :, 1], proj[:, :, 2], proj[:, :, 3]
    xw, xa = xs[:, :, 4], xs[:, :, 5]
    w_log = -jax.nn.softplus(-(w0 + jnp.tanh(xw @ w1) @ w2).astype(f32)) - 0.5
    decay = jnp.exp(-jnp.exp(w_log))
    a = jax.nn.sigmoid((a0 + (xa @ a1) @ a2).astype(f32))
    hd = lambda t: t.astype(f32).reshape(B, S, N_HEADS, HEAD_DIM)
    hp = lambda p: p.astype(f32).reshape(N_HEADS, HEAD_DIM)
    kk = hd(k * k_k)
    kk = kk / jnp.maximum(jnp.sqrt(jnp.sum(kk * kk, axis=-1, keepdims=True)), 1e-12)
    k_mod = hd(k) * (1.0 + (hd(a) - 1.0) * hp(k_a))
    r_h, v_h, a_h = hd(r), hd(v), hd(a)
    y = rwkv7_scan(r_h, hd(decay), k_mod, v_h, kk, a_h)
    mu = jnp.mean(y, axis=-1, keepdims=True)
    var = jnp.mean(jnp.square(y - mu), axis=-1, keepdims=True)
    y = (y - mu) * lax.rsqrt(var + LNX_EPS)
    y = y * hp(lnx_g) + hp(lnx_b)
    bonus = jnp.sum(r_h * k_mod * r_k.astype(f32), axis=-1, keepdims=True) * v_h
    o = (y + bonus).reshape(B, S, WIDTH).astype(x.dtype)
    return x + (o * jax.nn.silu(g)) @ w_out


def setup_inputs(seed: int = 0) -> dict:
    key = jax.random.key(seed)
    ks = jax.random.split(key, 24)
    nrm = lambda k, shape, s: jax.random.normal(k, shape, jnp.float32) * s
    D, W = D_MODEL, WIDTH
    return {
        "x": nrm(ks[0], (BATCH, SEQ, D), 1.0),
        "moba_norm_g": 1.0 + nrm(ks[1], (D,), 0.05),
        "moba_w_in": nrm(ks[2], (D, 4 * W), D ** -0.5),
        "moba_w_out": nrm(ks[3], (W, D), W ** -0.5),
        "rwkv_norm_g": 1.0 + nrm(ks[4], (D,), 0.05),
        "rwkv_mix": jax.random.uniform(ks[5], (N_SHIFT_STREAMS, D), jnp.float32),
        "rwkv_w_in": nrm(ks[6], (4, D, W), D ** -0.5),
        "rwkv_w0": jax.random.uniform(ks[7], (W,), jnp.float32, -4.0, 1.0),
        "rwkv_w1": nrm(ks[8], (D, DECAY_LORA), D ** -0.5),
        "rwkv_w2": nrm(ks[9], (DECAY_LORA, W), 0.3 * DECAY_LORA ** -0.5),
        "rwkv_a0": nrm(ks[10], (W,), 0.1),
        "rwkv_a1": nrm(ks[11], (D, AAA_LORA), D ** -0.5),
        "rwkv_a2": nrm(ks[12], (AAA_LORA, W), 0.3 * AAA_LORA ** -0.5),
        "rwkv_k_k": 0.85 + nrm(ks[13], (W,), 0.05),
        "rwkv_k_a": 1.0 + nrm(ks[14], (W,), 0.05),
        "rwkv_r_k": nrm(ks[15], (N_HEADS, HEAD_DIM), 0.1),
        "rwkv_lnx_g": 1.0 + nrm(ks[16], (W,), 0.05),
        "rwkv_lnx_b": nrm(ks[17], (W,), 0.02),
        "rwkv_w_out": nrm(ks[18], (W, D), W ** -0.5),
        "final_norm_g": 1.0 + nrm(ks[19], (D,), 0.05),
    }


def reference(x, moba_norm_g, moba_w_in, moba_w_out, rwkv_norm_g, rwkv_mix, rwkv_w_in,
              rwkv_w0, rwkv_w1, rwkv_w2, rwkv_a0, rwkv_a1, rwkv_a2, rwkv_k_k, rwkv_k_a,
              rwkv_r_k, rwkv_lnx_g, rwkv_lnx_b, rwkv_w_out, final_norm_g):
    moba_params = (moba_norm_g, moba_w_in, moba_w_out)
    rwkv_params = (rwkv_norm_g, rwkv_mix, rwkv_w_in, rwkv_w0, rwkv_w1, rwkv_w2, rwkv_a0,
                   rwkv_a1, rwkv_a2, rwkv_k_k, rwkv_k_a, rwkv_r_k, rwkv_lnx_g, rwkv_lnx_b,
                   rwkv_w_out)
    for i in range(DEPTH):
        if i % N_MIXERS == 0:
            x = moba_layer(x, *moba_params)
        else:
            x = rwkv7_layer(x, *rwkv_params)
    return rms_norm(x, final_norm_g)
```

```cpp
#include <hip/hip_runtime.h>
#include <cstdio>
#include <cstdint>
#include <cmath>

#define DEV __device__ __forceinline__
#define LAS __attribute__((address_space(3)))
#define GAS __attribute__((address_space(1)))

typedef unsigned short bf16_t;
typedef float f32x4 __attribute__((ext_vector_type(4)));
typedef float f32x2 __attribute__((ext_vector_type(2)));
typedef unsigned u32x4 __attribute__((ext_vector_type(4)));
typedef unsigned u32x2 __attribute__((ext_vector_type(2)));

constexpr int BATCH = 2, SEQ = 8192, DM = 1024, NH = 16, HD = 64, M = BATCH * SEQ;
constexpr int MBLK = 256, NBLK = SEQ / MBLK, TOPK = 3, LORA = 64;
constexpr float NORM_EPS = 1e-6f, LNX_EPS = 64e-5f;

constexpr int NWAVES = 8, NTHREADS = NWAVES * 64;
constexpr int N_PHASES = 10;
#ifndef MK_ONE_LAUNCH
#define MK_ONE_LAUNCH 1
#endif
constexpr int LDS_BYTES = 147456;

constexpr size_t MiB = 1u << 20;
constexpr size_t WS_CTL = 0, CTL_ZERO_BYTES = 1 * MiB;
constexpr size_t WS_KM = 1 * MiB;
constexpr size_t WS_LW = 2 * MiB, WS_LA = 6 * MiB;
constexpr size_t WS_H = 32 * MiB;
constexpr size_t WS_Q = 64 * MiB, WS_K = 96 * MiB, WS_V = 128 * MiB, WS_G = 160 * MiB;
constexpr size_t WS_OG = 192 * MiB;
constexpr size_t WS_END = 224 * MiB;
constexpr int CW_BAR = 4096;

DEV float bf2f(unsigned short u) { return __builtin_bit_cast(float, (unsigned)u << 16); }
DEV unsigned f2bf(float f) { unsigned u = __builtin_bit_cast(unsigned, f); return (u + 0x7fffu + ((u >> 16) & 1u)) >> 16; }
DEV unsigned pk2(float lo, float hi) { return f2bf(lo) | (f2bf(hi) << 16); }
DEV float wave_sum(float v) {
#pragma unroll
    for (int o = 1; o < 64; o <<= 1) v += __shfl_xor(v, o);
    return v;
}
DEV float wave_max(float v) {
#pragma unroll
    for (int o = 1; o < 64; o <<= 1) v = fmaxf(v, __shfl_xor(v, o));
    return v;
}
DEV float silu_f(float x) { return x / (1.f + __expf(-x)); }

#define XB_TMO      128
#define XB_XCNT(j)  (256  + 64 * (j))
#define XB_XSUB(j)  (1280 + 64 * (j))
#define XB_XGEN(j)  (2304 + 64 * (j))
#define XB_TOP      3328
#define XB_TOPGEN   3392
#define XCD_BAR_WORDS 3456
#define XB_SPIN_CAP (1u << 20)
DEV unsigned xb_ld(unsigned* p)              { return __hip_atomic_load(p, __ATOMIC_RELAXED, __HIP_MEMORY_SCOPE_AGENT); }
DEV unsigned xb_add(unsigned* p, unsigned v) { return __hip_atomic_fetch_add(p, v, __ATOMIC_RELAXED, __HIP_MEMORY_SCOPE_AGENT); }
DEV unsigned xb_xcc_id() { return (unsigned)__builtin_amdgcn_s_getreg((3 << 11) | 20) & 0xFu; }
#define XB_SPIN(cond, bar) do { unsigned _sp = 0; while (cond) { __builtin_amdgcn_s_sleep(1); \
    if ((++_sp & 255u) == 0u) { if (xb_ld(&(bar)[XB_TMO])) break; if (_sp > XB_SPIN_CAP) { atomicAdd(&(bar)[XB_TMO], 1u); break; } } } } while (0)
struct XcdBarrier { unsigned* bar; unsigned x; volatile LAS unsigned* st; };
DEV XcdBarrier xcd_barrier_post(unsigned* bar, volatile LAS unsigned* st) {
    XcdBarrier b; b.bar = bar; b.x = xb_xcc_id(); b.st = st;
    if (threadIdx.x == 0) (void)xb_add(&bar[XB_XCNT(b.x)], 1u);
    return b;
}
DEV void xcd_barrier_complete(unsigned* bar, unsigned x, unsigned& nloc, unsigned& nx) {
    const unsigned G = gridDim.x * gridDim.y * gridDim.z;
    unsigned sum, cnt, mine, sp = 0u;
    for (;;) {
        sum = 0u; cnt = 0u; mine = 0u;
#pragma unroll
        for (unsigned j = 0; j < 16; ++j) { const unsigned c = xb_ld(&bar[XB_XCNT(j)]); sum += c; cnt += (c > 0u) ? 1u : 0u; mine = (j == x) ? c : mine; }
        if (sum == G) break;
        __builtin_amdgcn_s_sleep(1);
        if ((++sp & 255u) == 0u) { if (xb_ld(&bar[XB_TMO])) break; if (sp > XB_SPIN_CAP) { atomicAdd(&bar[XB_TMO], 1u); break; } }
    }
    nloc = mine > 0u ? mine : 1u; nx = cnt > 0u ? cnt : 1u;
}
DEV void xcd_barrier(const XcdBarrier& b) {
    asm volatile("s_waitcnt vmcnt(0)" ::: "memory");
    __syncthreads();
    if (threadIdx.x == 0) {
        unsigned* bar = b.bar;
        __builtin_amdgcn_s_waitcnt(0);
        unsigned nloc = b.st[0], nx = b.st[1];
        if (nloc == 0u) { xcd_barrier_complete(bar, b.x, nloc, nx); b.st[0] = nloc; b.st[1] = nx; }
        const unsigned old = xb_add(&bar[XB_XSUB(b.x)], 1u);
        const unsigned gen = old / nloc;
        if (old + 1u == (gen + 1u) * nloc) {
            __builtin_amdgcn_fence(__ATOMIC_RELEASE, "agent");
            asm volatile("s_waitcnt vmcnt(0)" ::: "memory");
            const unsigned og = xb_add(&bar[XB_TOP], 1u);
            const unsigned tg = og / nx;
            if (og + 1u == (tg + 1u) * nx) xb_add(&bar[XB_TOPGEN], 1u);
            else XB_SPIN(xb_ld(&bar[XB_TOPGEN]) == tg, bar);
            __builtin_amdgcn_fence(__ATOMIC_ACQUIRE, "agent");
            xb_add(&bar[XB_XGEN(b.x)], 1u);
            asm volatile("s_waitcnt vmcnt(0)" ::: "memory");
        } else {
            XB_SPIN(xb_ld(&bar[XB_XGEN(b.x)]) == gen, bar);
            __builtin_amdgcn_fence(__ATOMIC_ACQUIRE, "agent");
            asm volatile("s_waitcnt vmcnt(0)" ::: "memory");
        }
    }
    __syncthreads();
}

struct Args { const float* in[20]; float* out; unsigned char* ws; int ph_lo, ph_hi; };
enum { I_X = 0, I_MNG, I_MWIN, I_MWOUT, I_RNG, I_RMIX, I_RWIN, I_W0, I_W1, I_W2, I_A0, I_A1, I_A2, I_KK, I_KA, I_RK, I_LNG, I_LNB, I_RWOUT, I_FNG };

template <bool OUT_BF16>
DEV void rms_rows(const float* xin, const float* g, bf16_t* ob, float* of, int gw, int ngw, int lane) {
    for (int m = gw; m < M; m += ngw) {
        const f32x4* xr = (const f32x4*)(xin + (size_t)m * DM) + lane;
        f32x4 v[4]; float s = 0.f;
#pragma unroll
        for (int j = 0; j < 4; ++j) { v[j] = xr[64 * j]; s += (v[j].x * v[j].x + v[j].y * v[j].y) + (v[j].z * v[j].z + v[j].w * v[j].w); }
        const float rstd = 1.f / sqrtf(wave_sum(s) * (1.f / DM) + NORM_EPS);
#pragma unroll
        for (int j = 0; j < 4; ++j) {
            const f32x4 gv = *((const f32x4*)g + lane + 64 * j);
            const f32x4 o = v[j] * rstd * gv;
            if (OUT_BF16) { u32x2 w; w.x = pk2(o.x, o.y); w.y = pk2(o.z, o.w); *((u32x2*)(ob + (size_t)m * DM) + lane + 64 * j) = w; }
            else *((f32x4*)(of + (size_t)m * DM) + lane + 64 * j) = o;
        }
    }
}

enum { EPI_BF16 = 0, EPI_RES = 1, EPI_TANH = 2, EPI_F32 = 3 };
template <int EPI>
DEV void gemm_naive(LAS unsigned char* lds, const bf16_t* A, const float* mix, const float* Bw, int ldb, int N,
                    bf16_t* Cb, size_t cb_stride1024, float* Cf, int ldcf, const float* res) {
    LAS float* As = (LAS float*)lds;
    LAS float* Bs = (LAS float*)(lds + 16 * 132 * 4);
    const int tid = threadIdx.x, ty = tid >> 4, tx = tid & 15;
    const int ntn = N / 64, ntiles = (M / 128) * ntn;
    for (int tile = blockIdx.x; tile < ntiles; tile += gridDim.x) {
        const int tm = tile / ntn, tn = tile % ntn, m0 = tm * 128, n0 = tn * 64;
        float acc[4][4];
#pragma unroll
        for (int i = 0; i < 4; ++i)
#pragma unroll
            for (int j = 0; j < 4; ++j) acc[i][j] = 0.f;
        const int arow = tid >> 2, akq = tid & 3;
        const int bkr = tid >> 5, bnc = (tid & 31) * 2;
        for (int k0 = 0; k0 < 1024; k0 += 16) {
            {
                const int m = m0 + arow, k = k0 + akq * 4;
                const u32x2 hw = *(const u32x2*)(A + (size_t)m * DM + k);
                float a0 = bf2f(hw.x & 0xffff), a1 = bf2f(hw.x >> 16), a2 = bf2f(hw.y & 0xffff), a3 = bf2f(hw.y >> 16);
                if (mix) {
                    float p0 = 0.f, p1 = 0.f, p2 = 0.f, p3 = 0.f;
                    if ((m % SEQ) != 0) { const u32x2 pw = *(const u32x2*)(A + (size_t)(m - 1) * DM + k);
                        p0 = bf2f(pw.x & 0xffff); p1 = bf2f(pw.x >> 16); p2 = bf2f(pw.y & 0xffff); p3 = bf2f(pw.y >> 16); }
                    const f32x4 mx = *(const f32x4*)(mix + k);
                    a0 += (p0 - a0) * mx.x; a1 += (p1 - a1) * mx.y; a2 += (p2 - a2) * mx.z; a3 += (p3 - a3) * mx.w;
                }
                As[(akq * 4 + 0) * 132 + arow] = a0; As[(akq * 4 + 1) * 132 + arow] = a1;
                As[(akq * 4 + 2) * 132 + arow] = a2; As[(akq * 4 + 3) * 132 + arow] = a3;
            }
            {
                const f32x2 bv = *(const f32x2*)(Bw + (size_t)(k0 + bkr) * ldb + n0 + bnc);
                Bs[bkr * 68 + bnc] = bv.x; Bs[bkr * 68 + bnc + 1] = bv.y;
            }
            __syncthreads();
#pragma unroll
            for (int kk = 0; kk < 16; ++kk) {
                const f32x4 a4 = *(const LAS f32x4*)(As + kk * 132 + ty * 4);
                const f32x4 b4 = *(const LAS f32x4*)(Bs + kk * 68 + tx * 4);
                const float av[4] = {a4.x, a4.y, a4.z, a4.w}, bv[4] = {b4.x, b4.y, b4.z, b4.w};
#pragma unroll
                for (int i = 0; i < 4; ++i)
#pragma unroll
                    for (int j = 0; j < 4; ++j) acc[i][j] += av[i] * bv[j];
            }
            __syncthreads();
        }
#pragma unroll
        for (int i = 0; i < 4; ++i) {
            const int m = m0 + ty * 4 + i, n = n0 + tx * 4;
            if (EPI == EPI_BF16) {
                bf16_t* dst = Cb + (size_t)(n >> 10) * cb_stride1024 + (size_t)m * DM + (n & 1023);
                u32x2 w; w.x = pk2(acc[i][0], acc[i][1]); w.y = pk2(acc[i][2], acc[i][3]); *(u32x2*)dst = w;
            } else if (EPI == EPI_RES) {
                const f32x4 r = *(const f32x4*)(res + (size_t)m * DM + n);
                *(f32x4*)(Cf + (size_t)m * DM + n) = (f32x4){r.x + acc[i][0], r.y + acc[i][1], r.z + acc[i][2], r.w + acc[i][3]};
            } else if (EPI == EPI_TANH) {
                *(f32x4*)(Cf + (size_t)m * ldcf + n) = (f32x4){tanhf(acc[i][0]), tanhf(acc[i][1]), tanhf(acc[i][2]), tanhf(acc[i][3])};
            } else {
                *(f32x4*)(Cf + (size_t)m * ldcf + n) = (f32x4){acc[i][0], acc[i][1], acc[i][2], acc[i][3]};
            }
        }
    }
}

DEV void kmean_naive(const bf16_t* Kb, float* KM, int gw, int ngw, int lane) {
    for (int it = gw; it < BATCH * NH * NBLK; it += ngw) {
        const int j = it % NBLK, h = (it / NBLK) % NH, b = it / (NBLK * NH);
        const bf16_t* kp = Kb + ((size_t)b * SEQ + (size_t)j * MBLK) * DM + h * HD + lane;
        float s = 0.f;
        for (int i = 0; i < MBLK; ++i) s += bf2f(kp[(size_t)i * DM]);
        KM[(size_t)it * HD + lane] = s * (1.f / MBLK);
    }
}

DEV void moba_naive(const bf16_t* Qb, const bf16_t* Kb, const bf16_t* Vb, const bf16_t* Gb, const float* KM, bf16_t* OG, int gw, int ngw, int lane) {
    for (int item = gw; item < M * NH; item += ngw) {
        const int t = item / NH, h = item % NH, b = t / SEQ, ts = t % SEQ, own = ts / MBLK;
        const float slope = exp2f(-0.5f * (float)(h + 1));
        const float qd = bf2f(Qb[(size_t)t * DM + h * HD + lane]);
        float myscore = -INFINITY;
        const float* kmp = KM + ((size_t)(b * NH + h) * NBLK) * HD + lane;
        for (int j = 0; j < own; ++j) { const float p = wave_sum(qd * kmp[(size_t)j * HD]); if (lane == j) myscore = p; }
        const int nsel = own < TOPK ? own : TOPK;
        int sel[4];
#pragma unroll
        for (int r = 0; r < TOPK; ++r) {
            const float mx = wave_max(myscore);
            const unsigned long long bal = __ballot(myscore == mx);
            const int sl = __builtin_amdgcn_readfirstlane((int)__builtin_ctzll(bal));
            sel[r] = sl; if (lane == sl) myscore = -INFINITY;
        }
        sel[3] = own;
        float q[64];
        {
            const u32x4* qp = (const u32x4*)(Qb + (size_t)t * DM + h * HD);
#pragma unroll
            for (int c = 0; c < 8; ++c) { const u32x4 w = qp[c];
                q[8 * c + 0] = bf2f(w.x & 0xffff); q[8 * c + 1] = bf2f(w.x >> 16); q[8 * c + 2] = bf2f(w.y & 0xffff); q[8 * c + 3] = bf2f(w.y >> 16);
                q[8 * c + 4] = bf2f(w.z & 0xffff); q[8 * c + 5] = bf2f(w.z >> 16); q[8 * c + 6] = bf2f(w.w & 0xffff); q[8 * c + 7] = bf2f(w.w >> 16); }
        }
        float sc[4][4]; float mx = -INFINITY;
#pragma unroll
        for (int s = 0; s < 4; ++s) {
            const bool valid = (s == 3) || (s < nsel);
#pragma unroll
            for (int i = 0; i < 4; ++i) sc[s][i] = -INFINITY;
            if (valid) {
                const int blk = sel[s];
#pragma unroll
                for (int i = 0; i < 4; ++i) {
                    const int pos = blk * MBLK + lane + 64 * i;
                    const u32x4* kp = (const u32x4*)(Kb + ((size_t)b * SEQ + pos) * DM + h * HD);
                    float d = 0.f;
#pragma unroll
                    for (int c = 0; c < 8; ++c) { const u32x4 w = kp[c];
                        d += q[8 * c + 0] * bf2f(w.x & 0xffff) + q[8 * c + 1] * bf2f(w.x >> 16) + q[8 * c + 2] * bf2f(w.y & 0xffff) + q[8 * c + 3] * bf2f(w.y >> 16)
                           + q[8 * c + 4] * bf2f(w.z & 0xffff) + q[8 * c + 5] * bf2f(w.z >> 16) + q[8 * c + 6] * bf2f(w.w & 0xffff) + q[8 * c + 7] * bf2f(w.w >> 16); }
                    float sv = d * 0.125f - slope * (float)(ts - pos);
                    if (s == 3 && pos > ts) sv = -INFINITY;
                    sc[s][i] = sv; mx = fmaxf(mx, sv);
                }
            }
        }
        mx = wave_max(mx);
        float l = 0.f;
#pragma unroll
        for (int s = 0; s < 4; ++s)
#pragma unroll
            for (int i = 0; i < 4; ++i) { const float p = __expf(sc[s][i] - mx); sc[s][i] = p; l += p; }
        l = wave_sum(l);
        float o = 0.f;
#pragma unroll
        for (int s = 0; s < 4; ++s) {
            const bool valid = (s == 3) || (s < nsel);
            if (valid) {
                const int blk = sel[s];
#pragma unroll
                for (int i = 0; i < 4; ++i) {
                    const bf16_t* vp = Vb + ((size_t)b * SEQ + (size_t)blk * MBLK + 64 * i) * DM + h * HD + lane;
                    const float pv = sc[s][i];
                    for (int ll = 0; ll < 64; ++ll) o += __shfl(pv, ll) * bf2f(vp[(size_t)ll * DM]);
                }
            }
        }
        const float gt = bf2f(Gb[(size_t)t * DM + h * HD + lane]);
        OG[(size_t)t * DM + h * HD + lane] = (bf16_t)f2bf(o / l * silu_f(gt));
    }
}

DEV void rwkv_naive(LAS unsigned char* lds, const Args& a, const bf16_t* Rb, const bf16_t* Kb, const bf16_t* Vb, const bf16_t* Gb,
                    const float* LW, const float* LA, bf16_t* OG) {
    LAS float* vec = (LAS float*)lds;
    LAS float* vv = (LAS float*)(lds + 5 * 4096 * 4);
    LAS float* yb = (LAS float*)(lds + 6 * 4096 * 4);
    const int tid = threadIdx.x, w = tid >> 6, lane = tid & 63;
    const float *w0 = a.in[I_W0], *w2 = a.in[I_W2], *a0 = a.in[I_A0], *a2 = a.in[I_A2], *k_k = a.in[I_KK], *k_a = a.in[I_KA], *r_k = a.in[I_RK], *lng = a.in[I_LNG], *lnb = a.in[I_LNB];
    for (int bh = blockIdx.x; bh < BATCH * NH; bh += gridDim.x) {
        const int b = bh / NH, h = bh % NH;
        float s[8];
#pragma unroll
        for (int i = 0; i < 8; ++i) s[i] = 0.f;
        const int row = 8 * w + (lane >> 3), ks = (lane & 7) * 8;
        for (int c = 0; c < SEQ / 64; ++c) {
            for (int i = 0; i < 8; ++i) {
                const int tl = 8 * w + i; const size_t t = (size_t)b * SEQ + c * 64 + tl; const int col = h * HD + lane;
                const float r = bf2f(Rb[t * DM + col]), k = bf2f(Kb[t * DM + col]), v = bf2f(Vb[t * DM + col]);
                float wp = w0[col], ap = a0[col];
                for (int j = 0; j < LORA; ++j) { wp += LW[t * LORA + j] * w2[(size_t)j * DM + col]; ap += LA[t * LORA + j] * a2[(size_t)j * DM + col]; }
                const float xm = -wp; const float sp = xm > 20.f ? xm : log1pf(expf(xm));
                const float wlog = -sp - 0.5f; const float dec = expf(-expf(wlog));
                const float av = 1.f / (1.f + expf(-ap));
                const float kkv = k * k_k[col];
                const float nrm = sqrtf(wave_sum(kkv * kkv));
                const float kkn = kkv / fmaxf(nrm, 1e-12f);
                const float kmod = k * (1.f + (av - 1.f) * k_a[col]);
                vec[0 * 4096 + tl * 64 + lane] = r; vec[1 * 4096 + tl * 64 + lane] = kmod; vec[2 * 4096 + tl * 64 + lane] = kkn;
                vec[3 * 4096 + tl * 64 + lane] = kkn * av; vec[4 * 4096 + tl * 64 + lane] = dec; vv[tl * 64 + lane] = v;
            }
            __syncthreads();
            for (int tl = 0; tl < 64; ++tl) {
                float r8[8], km8[8], kk8[8], ka8[8], de8[8];
#pragma unroll
                for (int hlf = 0; hlf < 2; ++hlf) {
                    const f32x4 x0 = *(const LAS f32x4*)(vec + 0 * 4096 + tl * 64 + ks + 4 * hlf), x1 = *(const LAS f32x4*)(vec + 1 * 4096 + tl * 64 + ks + 4 * hlf),
                                x2 = *(const LAS f32x4*)(vec + 2 * 4096 + tl * 64 + ks + 4 * hlf), x3 = *(const LAS f32x4*)(vec + 3 * 4096 + tl * 64 + ks + 4 * hlf),
                                x4 = *(const LAS f32x4*)(vec + 4 * 4096 + tl * 64 + ks + 4 * hlf);
                    r8[4 * hlf] = x0.x; r8[4 * hlf + 1] = x0.y; r8[4 * hlf + 2] = x0.z; r8[4 * hlf + 3] = x0.w;
                    km8[4 * hlf] = x1.x; km8[4 * hlf + 1] = x1.y; km8[4 * hlf + 2] = x1.z; km8[4 * hlf + 3] = x1.w;
                    kk8[4 * hlf] = x2.x; kk8[4 * hlf + 1] = x2.y; kk8[4 * hlf + 2] = x2.z; kk8[4 * hlf + 3] = x2.w;
                    ka8[4 * hlf] = x3.x; ka8[4 * hlf + 1] = x3.y; ka8[4 * hlf + 2] = x3.z; ka8[4 * hlf + 3] = x3.w;
                    de8[4 * hlf] = x4.x; de8[4 * hlf + 1] = x4.y; de8[4 * hlf + 2] = x4.z; de8[4 * hlf + 3] = x4.w;
                }
                const float vrow = vv[tl * 64 + row];
                float sa = 0.f;
#pragma unroll
                for (int i = 0; i < 8; ++i) sa -= s[i] * kk8[i];
                sa += __shfl_xor(sa, 1); sa += __shfl_xor(sa, 2); sa += __shfl_xor(sa, 4);
                float y = 0.f;
#pragma unroll
                for (int i = 0; i < 8; ++i) { s[i] = s[i] * de8[i] + sa * ka8[i] + vrow * km8[i]; y += s[i] * r8[i]; }
                y += __shfl_xor(y, 1); y += __shfl_xor(y, 2); y += __shfl_xor(y, 4);
                if ((lane & 7) == 0) yb[tl * 64 + row] = y;
            }
            __syncthreads();
            for (int i = 0; i < 8; ++i) {
                const int tl = 8 * w + i; const size_t t = (size_t)b * SEQ + c * 64 + tl; const int col = h * HD + lane;
                const float y = yb[tl * 64 + lane];
                const float mu = wave_sum(y) * (1.f / HD); const float dy = y - mu;
                const float var = wave_sum(dy * dy) * (1.f / HD);
                const float yn = dy * (1.f / sqrtf(var + LNX_EPS)) * lng[col] + lnb[col];
                const float bon = wave_sum(vec[0 * 4096 + tl * 64 + lane] * vec[1 * 4096 + tl * 64 + lane] * r_k[col]) * vv[tl * 64 + lane];
                const float gt = bf2f(Gb[t * DM + col]);
                OG[t * DM + col] = (bf16_t)f2bf((yn + bon) * silu_f(gt));
            }
            __syncthreads();
        }
    }
}

__global__ void __launch_bounds__(NTHREADS, 2) fwd_kernel(Args args) {
    extern __shared__ __attribute__((aligned(16))) unsigned char lds_raw[];
    LAS unsigned char* lds = (LAS unsigned char*)lds_raw;
    const int tid = threadIdx.x, lane = tid & 63, wave = __builtin_amdgcn_readfirstlane(tid >> 6);
    const int G = gridDim.x; const int gw = blockIdx.x * NWAVES + wave, ngw = G * NWAVES;
    unsigned char* ws = args.ws;
    unsigned* ctl = (unsigned*)(ws + WS_CTL);
    volatile LAS unsigned* MISC = (volatile LAS unsigned*)(lds + LDS_BYTES - 64);
    if (tid < 16) MISC[tid] = 0u;
    __syncthreads();
    XcdBarrier bar; bar.bar = ctl + CW_BAR; bar.x = 0; bar.st = nullptr;
    const int lo = args.ph_lo, hi = args.ph_hi;
    if (hi - lo > 1) bar = xcd_barrier_post(ctl + CW_BAR, MISC + 8);
#define IN(k) (lo <= (k) && (k) < hi)
#define SEAM(k) do { if (IN(k) && IN((k) + 1)) xcd_barrier(bar); } while (0)

    const float* x = args.in[I_X]; float* out = args.out;
    bf16_t* Hb = (bf16_t*)(ws + WS_H); bf16_t* Qb = (bf16_t*)(ws + WS_Q); bf16_t* Kb = (bf16_t*)(ws + WS_K); bf16_t* Vb = (bf16_t*)(ws + WS_V);
    bf16_t* Gb = (bf16_t*)(ws + WS_G); bf16_t* OG = (bf16_t*)(ws + WS_OG);
    float* KM = (float*)(ws + WS_KM); float* LW = (float*)(ws + WS_LW); float* LA = (float*)(ws + WS_LA);

    if (IN(0)) { rms_rows<true>(x, args.in[I_MNG], Hb, nullptr, gw, ngw, lane); } SEAM(0);
    if (IN(1)) { gemm_naive<EPI_BF16>(lds, Hb, nullptr, args.in[I_MWIN], 4 * DM, 4 * DM, Qb, (size_t)M * DM, nullptr, 0, nullptr); } SEAM(1);
    if (IN(2)) { kmean_naive(Kb, KM, gw, ngw, lane); } SEAM(2);
    if (IN(3)) { moba_naive(Qb, Kb, Vb, Gb, KM, OG, gw, ngw, lane); } SEAM(3);
    if (IN(4)) { gemm_naive<EPI_RES>(lds, OG, nullptr, args.in[I_MWOUT], DM, DM, nullptr, 0, out, DM, x); } SEAM(4);
    if (IN(5)) { rms_rows<true>(out, args.in[I_RNG], Hb, nullptr, gw, ngw, lane); } SEAM(5);
    if (IN(6)) {
        const float* mix = args.in[I_RMIX]; const float* win = args.in[I_RWIN];
        gemm_naive<EPI_BF16>(lds, Hb, mix + 0 * DM, win + (size_t)0 * DM * DM, DM, DM, Qb, 0, nullptr, 0, nullptr);
        gemm_naive<EPI_BF16>(lds, Hb, mix + 1 * DM, win + (size_t)1 * DM * DM, DM, DM, Kb, 0, nullptr, 0, nullptr);
        gemm_naive<EPI_BF16>(lds, Hb, mix + 2 * DM, win + (size_t)2 * DM * DM, DM, DM, Vb, 0, nullptr, 0, nullptr);
        gemm_naive<EPI_BF16>(lds, Hb, mix + 3 * DM, win + (size_t)3 * DM * DM, DM, DM, Gb, 0, nullptr, 0, nullptr);
        gemm_naive<EPI_TANH>(lds, Hb, mix + 4 * DM, args.in[I_W1], LORA, LORA, nullptr, 0, LW, LORA, nullptr);
        gemm_naive<EPI_F32>(lds, Hb, mix + 5 * DM, args.in[I_A1], LORA, LORA, nullptr, 0, LA, LORA, nullptr);
    } SEAM(6);
    if (IN(7)) { rwkv_naive(lds, args, Qb, Kb, Vb, Gb, LW, LA, OG); } SEAM(7);
    if (IN(8)) { gemm_naive<EPI_RES>(lds, OG, nullptr, args.in[I_RWOUT], DM, DM, nullptr, 0, out, DM, out); } SEAM(8);
    if (IN(9)) { rms_rows<false>(out, args.in[I_FNG], nullptr, out, gw, ngw, lane); }
#undef IN
#undef SEAM
}

extern "C" void kernel_launch(void* const* d_in, const int* in_sizes, int n_in, void* d_out, int out_size, void* d_ws, size_t ws_size, hipStream_t stream) {
    static int grid = 0;
    if (grid == 0) {
        if (n_in != 20 || in_sizes[0] != M * DM || out_size != M * DM || ws_size < WS_END) { fprintf(stderr, "kernel_launch: unexpected shapes (n_in %d, in0 %d, out %d, ws %zu)\n", n_in, n_in > 0 ? in_sizes[0] : -1, out_size, ws_size); grid = -1; return; }
        int dev = 0, cus = 0, per_cu = 0;
        if (hipGetDevice(&dev) != hipSuccess || hipDeviceGetAttribute(&cus, hipDeviceAttributeMultiprocessorCount, dev) != hipSuccess) { grid = -1; return; }
        if (hipFuncSetAttribute((const void*)fwd_kernel, hipFuncAttributeMaxDynamicSharedMemorySize, LDS_BYTES) != hipSuccess) { fprintf(stderr, "kernel_launch: hipFuncSetAttribute failed\n"); grid = -1; return; }
        if (hipOccupancyMaxActiveBlocksPerMultiprocessor(&per_cu, (const void*)fwd_kernel, NTHREADS, LDS_BYTES) != hipSuccess || per_cu < 1) { fprintf(stderr, "kernel_launch: occupancy query says %d blocks per CU\n", per_cu); per_cu = 1; }
        (void)hipGetLastError();
        grid = cus;
    }
    if (grid < 0) return;
    (void)hipMemsetAsync((char*)d_ws + WS_CTL, 0, CTL_ZERO_BYTES, stream);
    Args a{};
    for (int i = 0; i < 20; ++i) a.in[i] = (const float*)d_in[i];
    a.out = (float*)d_out; a.ws = (unsigned char*)d_ws;
    if (MK_ONE_LAUNCH) {
        a.ph_lo = 0; a.ph_hi = N_PHASES;
        hipLaunchKernelGGL(fwd_kernel, dim3(grid), dim3(NTHREADS), LDS_BYTES, stream, a);
    } else {
        for (int p = 0; p < N_PHASES; ++p) { a.ph_lo = p; a.ph_hi = p + 1; hipLaunchKernelGGL(fwd_kernel, dim3(grid), dim3(NTHREADS), LDS_BYTES, stream, a); }
    }
}
```

```cpp
#include <hip/hip_runtime.h>
#include <cstdio>
#include <cstdint>
#include <cmath>

#define DEV __device__ __forceinline__
#define LAS __attribute__((address_space(3)))
#define GAS __attribute__((address_space(1)))

typedef unsigned short bf16_t;
typedef float f32x4 __attribute__((ext_vector_type(4)));
typedef float f32x2 __attribute__((ext_vector_type(2)));
typedef unsigned u32x4 __attribute__((ext_vector_type(4)));
typedef unsigned u32x2 __attribute__((ext_vector_type(2)));

constexpr int BATCH = 2, SEQ = 8192, DM = 1024, NH = 16, HD = 64, M = BATCH * SEQ;
constexpr int MBLK = 256, NBLK = SEQ / MBLK, TOPK = 3, LORA = 64;
constexpr float NORM_EPS = 1e-6f, LNX_EPS = 64e-5f;

constexpr int NWAVES = 8, NTHREADS = NWAVES * 64;
constexpr int N_PHASES = 11;
#ifndef MK_ONE_LAUNCH
#define MK_ONE_LAUNCH 1
#endif
constexpr int LDS_BYTES = 147456;

constexpr size_t MiB = 1u << 20;
constexpr size_t WS_CTL = 0, CTL_ZERO_BYTES = 1 * MiB;
constexpr size_t WS_KM = 1 * MiB;
constexpr size_t WS_LW = 2 * MiB, WS_LA = 6 * MiB;
constexpr size_t WS_WIN0 = 10 * MiB, WS_WOUT0 = 18 * MiB, WS_WIN1 = 20 * MiB, WS_WOUT1 = 28 * MiB;
constexpr size_t WS_W1T = 30 * MiB, WS_A1T = 30 * MiB + 128 * 1024;
constexpr size_t WS_H0 = 32 * MiB, WS_L0 = 32 * MiB;
constexpr size_t WS_Q = 64 * MiB, WS_K = 96 * MiB, WS_V = 128 * MiB, WS_G = 160 * MiB;
constexpr size_t WS_H1 = 64 * MiB;
constexpr size_t WS_OG = 192 * MiB;
constexpr size_t WS_XS2 = 192 * MiB, WS_XS3 = 224 * MiB;
constexpr size_t WS_END = 256 * MiB;
constexpr int CW_BAR = 4096;

DEV float bf2f(unsigned short u) { return __builtin_bit_cast(float, (unsigned)u << 16); }
DEV unsigned f2bf(float f) { unsigned u = __builtin_bit_cast(unsigned, f); return (u + 0x7fffu + ((u >> 16) & 1u)) >> 16; }
DEV unsigned pk2(float lo, float hi) { return f2bf(lo) | (f2bf(hi) << 16); }
DEV float wave_sum(float v) {
#pragma unroll
    for (int o = 1; o < 64; o <<= 1) v += __shfl_xor(v, o);
    return v;
}
DEV float wave_max(float v) {
#pragma unroll
    for (int o = 1; o < 64; o <<= 1) v = fmaxf(v, __shfl_xor(v, o));
    return v;
}
DEV float silu_f(float x) { return x / (1.f + __expf(-x)); }

#define XB_TMO      128
#define XB_XCNT(j)  (256  + 64 * (j))
#define XB_XSUB(j)  (1280 + 64 * (j))
#define XB_XGEN(j)  (2304 + 64 * (j))
#define XB_TOP      3328
#define XB_TOPGEN   3392
#define XCD_BAR_WORDS 3456
#define XB_SPIN_CAP (1u << 20)
DEV unsigned xb_ld(unsigned* p)              { return __hip_atomic_load(p, __ATOMIC_RELAXED, __HIP_MEMORY_SCOPE_AGENT); }
DEV unsigned xb_add(unsigned* p, unsigned v) { return __hip_atomic_fetch_add(p, v, __ATOMIC_RELAXED, __HIP_MEMORY_SCOPE_AGENT); }
DEV unsigned xb_xcc_id() { return (unsigned)__builtin_amdgcn_s_getreg((3 << 11) | 20) & 0xFu; }
#define XB_SPIN(cond, bar) do { unsigned _sp = 0; while (cond) { __builtin_amdgcn_s_sleep(1); \
    if ((++_sp & 255u) == 0u) { if (xb_ld(&(bar)[XB_TMO])) break; if (_sp > XB_SPIN_CAP) { atomicAdd(&(bar)[XB_TMO], 1u); break; } } } } while (0)
struct XcdBarrier { unsigned* bar; unsigned x; volatile LAS unsigned* st; };
DEV XcdBarrier xcd_barrier_post(unsigned* bar, volatile LAS unsigned* st) {
    XcdBarrier b; b.bar = bar; b.x = xb_xcc_id(); b.st = st;
    if (threadIdx.x == 0) (void)xb_add(&bar[XB_XCNT(b.x)], 1u);
    return b;
}
DEV void xcd_barrier_complete(unsigned* bar, unsigned x, unsigned& nloc, unsigned& nx) {
    const unsigned G = gridDim.x * gridDim.y * gridDim.z;
    unsigned sum, cnt, mine, sp = 0u;
    for (;;) {
        sum = 0u; cnt = 0u; mine = 0u;
#pragma unroll
        for (unsigned j = 0; j < 16; ++j) { const unsigned c = xb_ld(&bar[XB_XCNT(j)]); sum += c; cnt += (c > 0u) ? 1u : 0u; mine = (j == x) ? c : mine; }
        if (sum == G) break;
        __builtin_amdgcn_s_sleep(1);
        if ((++sp & 255u) == 0u) { if (xb_ld(&bar[XB_TMO])) break; if (sp > XB_SPIN_CAP) { atomicAdd(&bar[XB_TMO], 1u); break; } }
    }
    nloc = mine > 0u ? mine : 1u; nx = cnt > 0u ? cnt : 1u;
}
DEV void xcd_barrier(const XcdBarrier& b) {
    asm volatile("s_waitcnt vmcnt(0)" ::: "memory");
    __syncthreads();
    if (threadIdx.x == 0) {
        unsigned* bar = b.bar;
        __builtin_amdgcn_s_waitcnt(0);
        unsigned nloc = b.st[0], nx = b.st[1];
        if (nloc == 0u) { xcd_barrier_complete(bar, b.x, nloc, nx); b.st[0] = nloc; b.st[1] = nx; }
        const unsigned old = xb_add(&bar[XB_XSUB(b.x)], 1u);
        const unsigned gen = old / nloc;
        if (old + 1u == (gen + 1u) * nloc) {
            __builtin_amdgcn_fence(__ATOMIC_RELEASE, "agent");
            asm volatile("s_waitcnt vmcnt(0)" ::: "memory");
            const unsigned og = xb_add(&bar[XB_TOP], 1u);
            const unsigned tg = og / nx;
            if (og + 1u == (tg + 1u) * nx) xb_add(&bar[XB_TOPGEN], 1u);
            else XB_SPIN(xb_ld(&bar[XB_TOPGEN]) == tg, bar);
            __builtin_amdgcn_fence(__ATOMIC_ACQUIRE, "agent");
            xb_add(&bar[XB_XGEN(b.x)], 1u);
            asm volatile("s_waitcnt vmcnt(0)" ::: "memory");
        } else {
            XB_SPIN(xb_ld(&bar[XB_XGEN(b.x)]) == gen, bar);
            __builtin_amdgcn_fence(__ATOMIC_ACQUIRE, "agent");
            asm volatile("s_waitcnt vmcnt(0)" ::: "memory");
        }
    }
    __syncthreads();
}

struct Args { const float* in[20]; float* out; unsigned char* ws; int ph_lo, ph_hi; };
enum { I_X = 0, I_MNG, I_MWIN, I_MWOUT, I_RNG, I_RMIX, I_RWIN, I_W0, I_W1, I_W2, I_A0, I_A1, I_A2, I_KK, I_KA, I_RK, I_LNG, I_LNB, I_RWOUT, I_FNG };

namespace pg8 {
#define PG8_LAS __attribute__((address_space(3)))
typedef unsigned short bf16_t;
typedef short bf16x8 __attribute__((ext_vector_type(8)));
typedef float f32x4 __attribute__((ext_vector_type(4)));
typedef unsigned u32x4 __attribute__((ext_vector_type(4)));
constexpr int BM = 256, BK = 64, HALF = 128, HTB = HALF * BK * 2  , STAGE_BYTES = 8 * HTB, NXCD = 8, WGM = 8;

__host__ __device__ __forceinline__ int lds_byte(int r, int c) { const int st = (r >> 4) * 2 + (c >> 5), rr = r & 15, cc = c & 31, ob = rr * 64 + cc * 2; return st * 1024 + (ob ^ (((ob >> 9) & 1) << 5)); }
__host__ __device__ __forceinline__ void stage_rc(int b, int& R, int& C) { const int st = b / 1024, sb = b % 1024, swz = sb ^ (((sb >> 9) & 1) << 5); R = (st >> 1) * 16 + swz / 64; C = (st & 1) * 32 + (swz % 64) / 2; }
__host__ __device__ __forceinline__ int perm32(int rho) { const int n = rho >> 4, i = rho & 15; return 8 * (i >> 2) + 4 * n + (i & 3); }

struct Unit { int pm, pn; };
struct Gemm { const bf16_t* A; const bf16_t* Bt; int M, N, K; const bf16_t* A1; const bf16_t* A2; const bf16_t* A3; int grouped; };
__device__ __forceinline__ const char* a_base(const Gemm& g, const Unit& u, size_t tstep) { const bf16_t* p = g.A; if (g.grouped) { const int s = u.pn >> 2; p = (s == 0) ? g.A : (s == 1) ? g.A1 : (s == 2) ? g.A2 : g.A3; } return (const char*)p + (size_t)u.pm * tstep; }

struct StaticOrder {
    int nM, nN, nwg, G, c;
    __host__ __device__ void init(int M, int N, int G_, int c_) { nM = M / BM; nN = N / BM; nwg = nM * nN; G = G_; c = c_; }
    __host__ __device__ bool next(int i, Unit& u) const {
        const long L = (long)i * G + c; if (L >= nwg) return false;
        int wgid = (int)L; { const int q = nwg / NXCD, r = nwg % NXCD, xcd = wgid % NXCD, off = wgid / NXCD; wgid = (xcd < r ? xcd * (q + 1) : r * (q + 1) + (xcd - r) * q) + off; }
        const int nig = WGM * nN, gid = wgid / nig, fm = gid * WGM, gsz = (nM - fm) < WGM ? (nM - fm) : WGM;
        u.pm = fm + ((wgid % nig) % gsz); u.pn = (wgid % nig) / gsz; return true;
    }
    __device__ __forceinline__ void a_ready(const Unit&) const {}
    __device__ __forceinline__ void done(const Unit&) const {}
};

__device__ __forceinline__ unsigned cvt_pk_bf16(float lo, float hi) { unsigned r; asm volatile("v_cvt_pk_bf16_f32 %0, %1, %2" : "=v"(r) : "v"(lo), "v"(hi)); return r; }
typedef float f32x2 __attribute__((ext_vector_type(2)));
__device__ __forceinline__ f32x2 gelu_pk(f32x2 v) {
    const f32x2 av = __builtin_elementwise_abs(v), d = av * 0.2316418882f + 1.0f;
    f32x2 t; t.x = __builtin_amdgcn_rcpf(d.x); t.y = __builtin_amdgcn_rcpf(d.y);
    f32x2 q = t * 0.5307027145f + (-0.7265760135f); q = q * t + 0.7107068705f; q = q * t + (-0.142248368f); q = q * t + 0.127414796f; q = q * t;
    const f32x2 s = (v * v) * (-0.72134752044f);
    f32x2 e; e.x = __builtin_amdgcn_exp2f(s.x); e.y = __builtin_amdgcn_exp2f(s.y);
    const f32x2 m = v * (q * e), r = v - m;
    f32x2 o; o.x = v.x < 0.f ? m.x : r.x; o.y = v.y < 0.f ? m.y : r.y; return o;
}

template <int ACT  > struct EpiBf16 {
    static constexpr bool PERM = true, AFTER_DRAIN = false; static_assert(ACT == 0 || ACT == 1, "EpiBf16: ACT is 0 (none) or 1 (gelu_pk)");
    bf16_t* O; int ldc; const float* bias; int split_cols; size_t split_stride; float scale0;
    __device__ __forceinline__ void operator()(const f32x4 (&acc)[2][2][4][2], const Unit& u, int wr, int wc, int fr, int fq) const {
        const int row0 = u.pm * BM + wr * 64 + fr; int colt = u.pn * BM; bf16_t* base = O;
        float sc = 1.f; if (split_cols) { const int t = colt / split_cols; base += (size_t)t * split_stride; colt -= t * split_cols; if (t == 0) sc = scale0; }
        const int col0 = colt + wc * 32 + 8 * fq, bcol0 = u.pn * BM + wc * 32 + 8 * fq;
        f32x4 bv[2][2];
#pragma unroll
        for (int bj = 0; bj < 2; ++bj)
#pragma unroll
            for (int n = 0; n < 2; ++n) bv[bj][n] = bias ? *(const f32x4*)(bias + bcol0 + bj * HALF + 4 * n) : (f32x4){0.f, 0.f, 0.f, 0.f};
#pragma unroll
        for (int ai = 0; ai < 2; ++ai)
#pragma unroll
            for (int m = 0; m < 4; ++m) { bf16_t* rowp = base + (size_t)(row0 + ai * HALF + m * 16) * ldc + col0;
#pragma unroll
                for (int bj = 0; bj < 2; ++bj) { f32x4 v0 = acc[ai][bj][m][0] + bv[bj][0], v1 = acc[ai][bj][m][1] + bv[bj][1];
                    if (ACT == 1) { f32x2 a = gelu_pk((f32x2){v0[0], v0[1]}), b = gelu_pk((f32x2){v0[2], v0[3]}), c = gelu_pk((f32x2){v1[0], v1[1]}), d = gelu_pk((f32x2){v1[2], v1[3]});
                        v0 = (f32x4){a.x, a.y, b.x, b.y}; v1 = (f32x4){c.x, c.y, d.x, d.y}; }
                    v0 = v0 * sc; v1 = v1 * sc; u32x4 w; w.x = cvt_pk_bf16(v0[0], v0[1]); w.y = cvt_pk_bf16(v0[2], v0[3]); w.z = cvt_pk_bf16(v1[0], v1[1]); w.w = cvt_pk_bf16(v1[2], v1[3]);
                    *(u32x4*)(rowp + bj * HALF) = w; } }
    }
};

struct EpiRes {
    static constexpr bool PERM = false, AFTER_DRAIN = false;
    const float* base; const bf16_t* l0in; bf16_t* l0out; float* out;
    __device__ __forceinline__ void operator()(const f32x4 (&acc)[2][2][4][2], const Unit& u, int wr, int wc, int fr, int fq) const {
        typedef unsigned u32x2v __attribute__((ext_vector_type(2)));
        const int col0 = u.pn * BM + wc * 32 + 4 * fq;
#pragma unroll
        for (int ai = 0; ai < 2; ++ai)
#pragma unroll
            for (int m = 0; m < 4; ++m) { const size_t roff = (size_t)(u.pm * BM + ai * HALF + wr * 64 + m * 16 + fr) * 1024 + col0;
#pragma unroll
                for (int bj = 0; bj < 2; ++bj)
#pragma unroll
                    for (int n = 0; n < 2; ++n) { const size_t off = roff + bj * HALF + n * 16; const f32x4 v = acc[ai][bj][m][n];
                        f32x4 b = *(const f32x4*)(base + off);
                        if (l0in) { const u32x2v w = *(const u32x2v*)(l0in + off);
                            b[0] += __builtin_bit_cast(float, w.x << 16); b[1] += __builtin_bit_cast(float, w.x & 0xffff0000u); b[2] += __builtin_bit_cast(float, w.y << 16); b[3] += __builtin_bit_cast(float, w.y & 0xffff0000u); }
                        if (l0out) { u32x2v w; w.x = cvt_pk_bf16(v[0], v[1]); w.y = cvt_pk_bf16(v[2], v[3]); *(u32x2v*)(l0out + off) = w; }
                        *(f32x4*)(out + off) = b + v; } }
    }
};

template <class Epi, class Sched, bool ALIGN_EPI = false, bool SP2 = false>
__device__ __forceinline__ void gemm_phase(PG8_LAS unsigned char* lds, const Gemm g, const Sched& S, const Epi& E) {
    const int tid = threadIdx.x, wid = __builtin_amdgcn_readfirstlane(tid >> 6), lane = tid & 63, wr = wid >> 2, wc = wid & 3, fr = lane & 15, fq = lane >> 4;
    const int K = g.K, nt = K / BK;
    unsigned voffA[2], voffB[2];
#pragma unroll
    for (int i = 0; i < 2; ++i) { int R, C; stage_rc(tid * 16 + i * 8192, R, C); const int Rb = Epi::PERM ? ((R & ~31) + perm32(R & 31)) : R;
        voffA[i] = (unsigned)(R * K + C) * 2u; voffB[i] = (unsigned)(Rb * K + C) * 2u; }
    const size_t kstep = (size_t)(BK * 2);
    const size_t hstep = (size_t)HALF * K * 2;
    const size_t tstep = 2 * hstep;
    const unsigned ldsw = (unsigned)wid * 1024u;
    const int aoff = lds_byte(wr * 64 + fr, fq * 8), boff = lds_byte(wc * 32 + fr, fq * 8);
#define PG8_SA(b, h) (((b) * 2 + (h)) * HTB)
#define PG8_SB(b, h) ((4 + (b) * 2 + (h)) * HTB)
#define PG8_STAGE(bufoff, gbase, voff) do { _Pragma("unroll") for (int _i = 0; _i < 2; ++_i) \
        __builtin_amdgcn_global_load_lds((const unsigned*)((const char*)(gbase) + (voff)[_i]), (PG8_LAS unsigned*)(lds + (bufoff) + ldsw + _i * 8192), 16, 0, 0); } while (0)
#define PG8_LDA(dst, b, h) do { _Pragma("unroll") for (int m = 0; m < 4; ++m) _Pragma("unroll") for (int k = 0; k < 2; ++k) dst[m][k] = *(const PG8_LAS bf16x8*)(lds + PG8_SA(b, h) + aoff + m * 2048 + k * 1024); } while (0)
#define PG8_LDB(dst, b, h) do { _Pragma("unroll") for (int n = 0; n < 2; ++n) _Pragma("unroll") for (int k = 0; k < 2; ++k) dst[n][k] = *(const PG8_LAS bf16x8*)(lds + PG8_SB(b, h) + boff + n * 2048 + k * 1024); } while (0)
#define PG8_MMA(ai, bj, At, Bt) do { __builtin_amdgcn_s_setprio(1); _Pragma("unroll") for (int m = 0; m < 4; ++m) _Pragma("unroll") for (int n = 0; n < 2; ++n) _Pragma("unroll") for (int k = 0; k < 2; ++k) \
        acc[ai][bj][m][n] = __builtin_amdgcn_mfma_f32_16x16x32_bf16(Bt[n][k], At[m][k], acc[ai][bj][m][n], 0, 0, 0); __builtin_amdgcn_s_setprio(0); } while (0)
#define PG8_WAIT_V(n) asm volatile("s_waitcnt vmcnt(" #n ")" ::: "memory")
#define PG8_WAIT_L(n) asm volatile("s_waitcnt lgkmcnt(" #n ")" ::: "memory")
#define PG8_BAR __builtin_amdgcn_s_barrier()
#define PG8_SCHED __builtin_amdgcn_sched_barrier(0)
    Unit cur, nxt; int ui = 0;
    if (!S.next(0, cur)) return;
    f32x4 acc[2][2][4][2];
#pragma unroll
    for (int a = 0; a < 2; ++a)
#pragma unroll
        for (int b = 0; b < 2; ++b)
#pragma unroll
            for (int m = 0; m < 4; ++m)
#pragma unroll
                for (int n = 0; n < 2; ++n) acc[a][b][m][n] = (f32x4){0.f, 0.f, 0.f, 0.f};
    bf16x8 At[4][2], B0[2][2], B1[2][2];
    const char* cA = a_base(g, cur, tstep); const char* cB = (const char*)g.Bt + (size_t)cur.pn * tstep;
    S.a_ready(cur);
    if constexpr (SP2) {
        PG8_STAGE(PG8_SB(0, 0), cB, voffB); PG8_STAGE(PG8_SB(0, 1), cB + hstep, voffB); PG8_STAGE(PG8_SA(0, 0), cA, voffA); PG8_STAGE(PG8_SA(0, 1), cA + hstep, voffA);
        if (wr == 1) PG8_BAR;
        PG8_WAIT_V(2); PG8_BAR;
        PG8_STAGE(PG8_SB(1, 0), cB + kstep, voffB); PG8_STAGE(PG8_SA(1, 0), cA + kstep, voffA); PG8_STAGE(PG8_SB(1, 1), cB + hstep + kstep, voffB);
        PG8_WAIT_V(6); PG8_BAR;
    } else {
        PG8_STAGE(PG8_SB(0, 0), cB, voffB); PG8_STAGE(PG8_SA(0, 0), cA, voffA); PG8_STAGE(PG8_SB(0, 1), cB + hstep, voffB); PG8_STAGE(PG8_SA(0, 1), cA + hstep, voffA);
        if (wr == 1) PG8_BAR;
        PG8_WAIT_V(4); PG8_BAR;
        PG8_STAGE(PG8_SB(1, 0), cB + kstep, voffB); PG8_STAGE(PG8_SA(1, 0), cA + kstep, voffA); PG8_STAGE(PG8_SB(1, 1), cB + hstep + kstep, voffB);
        PG8_WAIT_V(6); PG8_BAR;
    }
    for (;;) {
        const bool has_next = S.next(ui + 1, nxt);
        const char* nA = has_next ? a_base(g, nxt, tstep) : cA; const char* nB = has_next ? (const char*)g.Bt + (size_t)nxt.pn * tstep : cB;
        for (int t = 0; t < nt; t += 2) {
            const bool last = (t == nt - 2);
            const char* a1 = cA + (size_t)(t + 1) * kstep;
            const char* a2 = last ? nA : cA + (size_t)(t + 2) * kstep; const char* b2 = last ? nB : cB + (size_t)(t + 2) * kstep;
            const char* a3 = a2 + kstep; const char* b3 = b2 + kstep;
            if (last && has_next) S.a_ready(nxt);
            if constexpr (SP2) {
            PG8_LDB(B0, 0, 0); PG8_LDB(B1, 0, 1); PG8_SCHED; PG8_LDA(At, 0, 0); PG8_STAGE(PG8_SA(1, 1), a1 + hstep, voffA);
            PG8_WAIT_V(8); PG8_WAIT_L(0); PG8_BAR; PG8_MMA(0, 0, At, B0); PG8_MMA(0, 1, At, B1); PG8_BAR; PG8_SCHED;
            PG8_LDA(At, 0, 1); PG8_STAGE(PG8_SB(0, 0), b2, voffB); PG8_STAGE(PG8_SB(0, 1), b2 + hstep, voffB); PG8_STAGE(PG8_SA(0, 0), a2, voffA);
            PG8_WAIT_V(8); PG8_WAIT_L(0); PG8_BAR; PG8_MMA(1, 0, At, B0); PG8_MMA(1, 1, At, B1); PG8_BAR; PG8_SCHED;
            PG8_LDB(B0, 1, 0); PG8_LDB(B1, 1, 1); PG8_SCHED; PG8_LDA(At, 1, 0); PG8_STAGE(PG8_SA(0, 1), a2 + hstep, voffA);
            PG8_WAIT_V(8); PG8_WAIT_L(0); PG8_BAR; PG8_MMA(0, 0, At, B0); PG8_MMA(0, 1, At, B1); PG8_BAR; PG8_SCHED;
            PG8_LDA(At, 1, 1); PG8_STAGE(PG8_SB(1, 0), b3, voffB); PG8_STAGE(PG8_SB(1, 1), b3 + hstep, voffB); PG8_STAGE(PG8_SA(1, 0), a3, voffA);
            PG8_WAIT_V(8); PG8_WAIT_L(0); PG8_BAR; PG8_MMA(1, 0, At, B0); PG8_MMA(1, 1, At, B1); PG8_BAR; PG8_SCHED;
            } else {
            PG8_LDB(B0, 0, 0); PG8_SCHED; PG8_LDA(At, 0, 0); PG8_STAGE(PG8_SA(1, 1), a1 + hstep, voffA);
            PG8_WAIT_L(8); PG8_BAR; PG8_WAIT_L(0); PG8_MMA(0, 0, At, B0); PG8_BAR; PG8_SCHED;
            PG8_LDB(B1, 0, 1); PG8_STAGE(PG8_SB(0, 0), b2, voffB);
            PG8_BAR; PG8_WAIT_L(0); PG8_MMA(0, 1, At, B1); PG8_BAR;
            PG8_LDA(At, 0, 1); PG8_STAGE(PG8_SA(0, 0), a2, voffA);
            PG8_BAR; PG8_WAIT_L(0); PG8_MMA(1, 0, At, B0); PG8_BAR; PG8_SCHED;
            PG8_STAGE(PG8_SB(0, 1), b2 + hstep, voffB);
            PG8_WAIT_V(6); PG8_BAR; PG8_MMA(1, 1, At, B1); PG8_BAR;
            PG8_LDB(B0, 1, 0); PG8_SCHED; PG8_LDA(At, 1, 0); PG8_STAGE(PG8_SA(0, 1), a2 + hstep, voffA);
            PG8_WAIT_L(8); PG8_BAR; PG8_WAIT_L(0); PG8_MMA(0, 0, At, B0); PG8_BAR; PG8_SCHED;
            PG8_LDB(B1, 1, 1); PG8_STAGE(PG8_SB(1, 0), b3, voffB);
            PG8_BAR; PG8_WAIT_L(0); PG8_MMA(0, 1, At, B1); PG8_BAR;
            PG8_LDA(At, 1, 1); PG8_STAGE(PG8_SA(1, 0), a3, voffA);
            PG8_BAR; PG8_WAIT_L(0); PG8_MMA(1, 0, At, B0); PG8_BAR; PG8_SCHED;
            PG8_STAGE(PG8_SB(1, 1), b3 + hstep, voffB);
            PG8_WAIT_V(6); PG8_BAR; PG8_MMA(1, 1, At, B1); PG8_BAR;
            }
        }
        if constexpr (ALIGN_EPI) { if (wr == 0) PG8_BAR; }
        if constexpr (!Epi::AFTER_DRAIN) { E(acc, cur, wr, wc, fr, fq); S.done(cur); }
        if (!has_next) break;
#pragma unroll
        for (int a = 0; a < 2; ++a)
#pragma unroll
            for (int b = 0; b < 2; ++b)
#pragma unroll
                for (int m = 0; m < 4; ++m)
#pragma unroll
                    for (int n = 0; n < 2; ++n) acc[a][b][m][n] = (f32x4){0.f, 0.f, 0.f, 0.f};
        cur = nxt; cA = nA; cB = nB; ++ui;
        if constexpr (ALIGN_EPI) { if (wr == 1) PG8_BAR; }
    }
    PG8_WAIT_V(0);
    if constexpr (!ALIGN_EPI) { if (wr == 0) PG8_BAR; }
    PG8_BAR;
    if constexpr (Epi::AFTER_DRAIN) { E.fused(acc, cur, wr, wc, fr, fq, lds, wid, lane); S.done(cur); }
#undef PG8_SA
#undef PG8_SB
#undef PG8_STAGE
#undef PG8_LDA
#undef PG8_LDB
#undef PG8_MMA
#undef PG8_WAIT_V
#undef PG8_WAIT_L
#undef PG8_BAR
#undef PG8_SCHED
}
}
template <bool OUT_BF16>
DEV void rms_rows(const float* xin, const float* g, bf16_t* ob, float* of, int gw, int ngw, int lane) {
    for (int m = gw; m < M; m += ngw) {
        const f32x4* xr = (const f32x4*)(xin + (size_t)m * DM) + lane;
        f32x4 v[4]; float s = 0.f;
#pragma unroll
        for (int j = 0; j < 4; ++j) { v[j] = xr[64 * j]; s += (v[j].x * v[j].x + v[j].y * v[j].y) + (v[j].z * v[j].z + v[j].w * v[j].w); }
        const float rstd = 1.f / sqrtf(wave_sum(s) * (1.f / DM) + NORM_EPS);
#pragma unroll
        for (int j = 0; j < 4; ++j) {
            const f32x4 gv = *((const f32x4*)g + lane + 64 * j);
            const f32x4 o = v[j] * rstd * gv;
            if (OUT_BF16) { u32x2 w; w.x = pk2(o.x, o.y); w.y = pk2(o.z, o.w); *((u32x2*)(ob + (size_t)m * DM) + lane + 64 * j) = w; }
            else *((f32x4*)(of + (size_t)m * DM) + lane + 64 * j) = o;
        }
    }
}

DEV void kmean_naive(const bf16_t* Kb, float* KM, int gw, int ngw, int lane) {
    for (int it = gw; it < BATCH * NH * NBLK; it += ngw) {
        const int j = it % NBLK, h = (it / NBLK) % NH, b = it / (NBLK * NH);
        const bf16_t* kp = Kb + ((size_t)b * SEQ + (size_t)j * MBLK) * DM + h * HD + lane;
        float s = 0.f;
        for (int i = 0; i < MBLK; ++i) s += bf2f(kp[(size_t)i * DM]);
        KM[(size_t)it * HD + lane] = s * (1.f / MBLK);
    }
}

DEV void moba_naive(const bf16_t* Qb, const bf16_t* Kb, const bf16_t* Vb, const bf16_t* Gb, const float* KM, bf16_t* OG, int gw, int ngw, int lane) {
    for (int item = gw; item < M * NH; item += ngw) {
        const int t = item / NH, h = item % NH, b = t / SEQ, ts = t % SEQ, own = ts / MBLK;
        const float slope = exp2f(-0.5f * (float)(h + 1));
        const float qd = bf2f(Qb[(size_t)t * DM + h * HD + lane]);
        float myscore = -INFINITY;
        const float* kmp = KM + ((size_t)(b * NH + h) * NBLK) * HD + lane;
        for (int j = 0; j < own; ++j) { const float p = wave_sum(qd * kmp[(size_t)j * HD]); if (lane == j) myscore = p; }
        const int nsel = own < TOPK ? own : TOPK;
        int sel[4];
#pragma unroll
        for (int r = 0; r < TOPK; ++r) {
            const float mx = wave_max(myscore);
            const unsigned long long bal = __ballot(myscore == mx);
            const int sl = __builtin_amdgcn_readfirstlane((int)__builtin_ctzll(bal));
            sel[r] = sl; if (lane == sl) myscore = -INFINITY;
        }
        sel[3] = own;
        float q[64];
        {
            const u32x4* qp = (const u32x4*)(Qb + (size_t)t * DM + h * HD);
#pragma unroll
            for (int c = 0; c < 8; ++c) { const u32x4 w = qp[c];
                q[8 * c + 0] = bf2f(w.x & 0xffff); q[8 * c + 1] = bf2f(w.x >> 16); q[8 * c + 2] = bf2f(w.y & 0xffff); q[8 * c + 3] = bf2f(w.y >> 16);
                q[8 * c + 4] = bf2f(w.z & 0xffff); q[8 * c + 5] = bf2f(w.z >> 16); q[8 * c + 6] = bf2f(w.w & 0xffff); q[8 * c + 7] = bf2f(w.w >> 16); }
        }
        float sc[4][4]; float mx = -INFINITY;
#pragma unroll
        for (int s = 0; s < 4; ++s) {
            const bool valid = (s == 3) || (s < nsel);
#pragma unroll
            for (int i = 0; i < 4; ++i) sc[s][i] = -INFINITY;
            if (valid) {
                const int blk = sel[s];
#pragma unroll
                for (int i = 0; i < 4; ++i) {
                    const int pos = blk * MBLK + lane + 64 * i;
                    const u32x4* kp = (const u32x4*)(Kb + ((size_t)b * SEQ + pos) * DM + h * HD);
                    float d = 0.f;
#pragma unroll
                    for (int c = 0; c < 8; ++c) { const u32x4 w = kp[c];
                        d += q[8 * c + 0] * bf2f(w.x & 0xffff) + q[8 * c + 1] * bf2f(w.x >> 16) + q[8 * c + 2] * bf2f(w.y & 0xffff) + q[8 * c + 3] * bf2f(w.y >> 16)
                           + q[8 * c + 4] * bf2f(w.z & 0xffff) + q[8 * c + 5] * bf2f(w.z >> 16) + q[8 * c + 6] * bf2f(w.w & 0xffff) + q[8 * c + 7] * bf2f(w.w >> 16); }
                    float sv = d * 0.125f - slope * (float)(ts - pos);
                    if (s == 3 && pos > ts) sv = -INFINITY;
                    sc[s][i] = sv; mx = fmaxf(mx, sv);
                }
            }
        }
        mx = wave_max(mx);
        float l = 0.f;
#pragma unroll
        for (int s = 0; s < 4; ++s)
#pragma unroll
            for (int i = 0; i < 4; ++i) { const float p = __expf(sc[s][i] - mx); sc[s][i] = p; l += p; }
        l = wave_sum(l);
        float o = 0.f;
#pragma unroll
        for (int s = 0; s < 4; ++s) {
            const bool valid = (s == 3) || (s < nsel);
            if (valid) {
                const int blk = sel[s];
#pragma unroll
                for (int i = 0; i < 4; ++i) {
                    const bf16_t* vp = Vb + ((size_t)b * SEQ + (size_t)blk * MBLK + 64 * i) * DM + h * HD + lane;
                    const float pv = sc[s][i];
                    for (int ll = 0; ll < 64; ++ll) o += __shfl(pv, ll) * bf2f(vp[(size_t)ll * DM]);
                }
            }
        }
        const float gt = bf2f(Gb[(size_t)t * DM + h * HD + lane]);
        OG[(size_t)t * DM + h * HD + lane] = (bf16_t)f2bf(o / l * silu_f(gt));
    }
}

DEV void rwkv_naive(LAS unsigned char* lds, const Args& a, const bf16_t* Rb, const bf16_t* Kb, const bf16_t* Vb, const bf16_t* Gb,
                    const float* LW, const float* LA, bf16_t* OG) {
    LAS float* vec = (LAS float*)lds;
    LAS float* vv = (LAS float*)(lds + 5 * 4096 * 4);
    LAS float* yb = (LAS float*)(lds + 6 * 4096 * 4);
    const int tid = threadIdx.x, w = tid >> 6, lane = tid & 63;
    const float *w0 = a.in[I_W0], *w2 = a.in[I_W2], *a0 = a.in[I_A0], *a2 = a.in[I_A2], *k_k = a.in[I_KK], *k_a = a.in[I_KA], *r_k = a.in[I_RK], *lng = a.in[I_LNG], *lnb = a.in[I_LNB];
    for (int bh = blockIdx.x; bh < BATCH * NH; bh += gridDim.x) {
        const int b = bh / NH, h = bh % NH;
        float s[8];
#pragma unroll
        for (int i = 0; i < 8; ++i) s[i] = 0.f;
        const int row = 8 * w + (lane >> 3), ks = (lane & 7) * 8;
        for (int c = 0; c < SEQ / 64; ++c) {
            for (int i = 0; i < 8; ++i) {
                const int tl = 8 * w + i; const size_t t = (size_t)b * SEQ + c * 64 + tl; const int col = h * HD + lane;
                const float r = bf2f(Rb[t * DM + col]), k = bf2f(Kb[t * DM + col]), v = bf2f(Vb[t * DM + col]);
                float wp = w0[col], ap = a0[col];
                for (int j = 0; j < LORA; ++j) { wp += LW[t * LORA + j] * w2[(size_t)j * DM + col]; ap += LA[t * LORA + j] * a2[(size_t)j * DM + col]; }
                const float xm = -wp; const float sp = xm > 20.f ? xm : log1pf(expf(xm));
                const float wlog = -sp - 0.5f; const float dec = expf(-expf(wlog));
                const float av = 1.f / (1.f + expf(-ap));
                const float kkv = k * k_k[col];
                const float nrm = sqrtf(wave_sum(kkv * kkv));
                const float kkn = kkv / fmaxf(nrm, 1e-12f);
                const float kmod = k * (1.f + (av - 1.f) * k_a[col]);
                vec[0 * 4096 + tl * 64 + lane] = r; vec[1 * 4096 + tl * 64 + lane] = kmod; vec[2 * 4096 + tl * 64 + lane] = kkn;
                vec[3 * 4096 + tl * 64 + lane] = kkn * av; vec[4 * 4096 + tl * 64 + lane] = dec; vv[tl * 64 + lane] = v;
            }
            __syncthreads();
            for (int tl = 0; tl < 64; ++tl) {
                float r8[8], km8[8], kk8[8], ka8[8], de8[8];
#pragma unroll
                for (int hlf = 0; hlf < 2; ++hlf) {
                    const f32x4 x0 = *(const LAS f32x4*)(vec + 0 * 4096 + tl * 64 + ks + 4 * hlf), x1 = *(const LAS f32x4*)(vec + 1 * 4096 + tl * 64 + ks + 4 * hlf),
                                x2 = *(const LAS f32x4*)(vec + 2 * 4096 + tl * 64 + ks + 4 * hlf), x3 = *(const LAS f32x4*)(vec + 3 * 4096 + tl * 64 + ks + 4 * hlf),
                                x4 = *(const LAS f32x4*)(vec + 4 * 4096 + tl * 64 + ks + 4 * hlf);
                    r8[4 * hlf] = x0.x; r8[4 * hlf + 1] = x0.y; r8[4 * hlf + 2] = x0.z; r8[4 * hlf + 3] = x0.w;
                    km8[4 * hlf] = x1.x; km8[4 * hlf + 1] = x1.y; km8[4 * hlf + 2] = x1.z; km8[4 * hlf + 3] = x1.w;
                    kk8[4 * hlf] = x2.x; kk8[4 * hlf + 1] = x2.y; kk8[4 * hlf + 2] = x2.z; kk8[4 * hlf + 3] = x2.w;
                    ka8[4 * hlf] = x3.x; ka8[4 * hlf + 1] = x3.y; ka8[4 * hlf + 2] = x3.z; ka8[4 * hlf + 3] = x3.w;
                    de8[4 * hlf] = x4.x; de8[4 * hlf + 1] = x4.y; de8[4 * hlf + 2] = x4.z; de8[4 * hlf + 3] = x4.w;
                }
                const float vrow = vv[tl * 64 + row];
                float sa = 0.f;
#pragma unroll
                for (int i = 0; i < 8; ++i) sa -= s[i] * kk8[i];
                sa += __shfl_xor(sa, 1); sa += __shfl_xor(sa, 2); sa += __shfl_xor(sa, 4);
                float y = 0.f;
#pragma unroll
                for (int i = 0; i < 8; ++i) { s[i] = s[i] * de8[i] + sa * ka8[i] + vrow * km8[i]; y += s[i] * r8[i]; }
                y += __shfl_xor(y, 1); y += __shfl_xor(y, 2); y += __shfl_xor(y, 4);
                if ((lane & 7) == 0) yb[tl * 64 + row] = y;
            }
            __syncthreads();
            for (int i = 0; i < 8; ++i) {
                const int tl = 8 * w + i; const size_t t = (size_t)b * SEQ + c * 64 + tl; const int col = h * HD + lane;
                const float y = yb[tl * 64 + lane];
                const float mu = wave_sum(y) * (1.f / HD); const float dy = y - mu;
                const float var = wave_sum(dy * dy) * (1.f / HD);
                const float yn = dy * (1.f / sqrtf(var + LNX_EPS)) * lng[col] + lnb[col];
                const float bon = wave_sum(vec[0 * 4096 + tl * 64 + lane] * vec[1 * 4096 + tl * 64 + lane] * r_k[col]) * vv[tl * 64 + lane];
                const float gt = bf2f(Gb[t * DM + col]);
                OG[t * DM + col] = (bf16_t)f2bf((yn + bon) * silu_f(gt));
            }
            __syncthreads();
        }
    }
}


#define LDS_WAIT() asm volatile("s_waitcnt lgkmcnt(0)" ::: "memory")
__device__ __forceinline__ void p0_transpose_item(const float* W, int K, int N, bf16_t* WT, int row_off, LAS float* scr, int item, int lane) {
    const int nblk = N / 32, kb = item / nblk, nb = item % nblk, k0 = 64 * kb, n0 = 32 * nb;
#pragma unroll 8
    for (int i = 0; i < 32; ++i) { const int kk = 2 * i + (lane >> 5); scr[kk * 33 + (lane & 31)] = W[(size_t)(k0 + kk) * N + n0 + (lane & 31)]; }
    LDS_WAIT(); asm volatile("" ::: "memory");
    const int c = lane & 7;
#pragma unroll
    for (int j = 0; j < 4; ++j) { const int n = (lane >> 3) + 8 * j; const LAS float* s = scr + (8 * c) * 33 + n;
        u32x4 o; o.x = pk2(s[0 * 33], s[1 * 33]); o.y = pk2(s[2 * 33], s[3 * 33]); o.z = pk2(s[4 * 33], s[5 * 33]); o.w = pk2(s[6 * 33], s[7 * 33]);
        *(GAS u32x4*)(WT + (size_t)(row_off + n0 + n) * K + k0 + 8 * c) = o; }
    LDS_WAIT(); asm volatile("" ::: "memory");
}

DEV void p0_prologue(LAS unsigned char* lds, const Args& a, unsigned char* ws, int gw, int ngw, int wave, int lane) {
    LAS float* scr = (LAS float*)(lds + wave * 16384);
    constexpr int I_IN = (DM / 64) * (4 * DM / 32), I_SQ = (DM / 64) * (DM / 32), I_LO = (DM / 64) * (LORA / 32);
    constexpr int NITEMS = I_IN + I_SQ + 4 * I_SQ + I_SQ + 2 * I_LO;
    bf16_t* win0 = (bf16_t*)(ws + WS_WIN0); bf16_t* wout0 = (bf16_t*)(ws + WS_WOUT0); bf16_t* win1 = (bf16_t*)(ws + WS_WIN1); bf16_t* wout1 = (bf16_t*)(ws + WS_WOUT1);
    bf16_t* w1t = (bf16_t*)(ws + WS_W1T); bf16_t* a1t = (bf16_t*)(ws + WS_A1T);
    for (int it = gw; it < NITEMS; it += ngw) {
        int r = it;
        if (r < I_IN) { p0_transpose_item(a.in[I_MWIN], DM, 4 * DM, win0, 0, scr, r, lane); continue; } r -= I_IN;
        if (r < I_SQ) { p0_transpose_item(a.in[I_MWOUT], DM, DM, wout0, 0, scr, r, lane); continue; } r -= I_SQ;
        if (r < 4 * I_SQ) { const int s = r / I_SQ; p0_transpose_item(a.in[I_RWIN] + (size_t)s * DM * DM, DM, DM, win1, s * DM, scr, r % I_SQ, lane); continue; } r -= 4 * I_SQ;
        if (r < I_SQ) { p0_transpose_item(a.in[I_RWOUT], DM, DM, wout1, 0, scr, r, lane); continue; } r -= I_SQ;
        if (r < I_LO) { p0_transpose_item(a.in[I_W1], DM, LORA, w1t, 0, scr, r, lane); continue; } r -= I_LO;
        p0_transpose_item(a.in[I_A1], DM, LORA, a1t, 0, scr, r, lane);
    }
    rms_rows<true>(a.in[I_X], a.in[I_MNG], (bf16_t*)(ws + WS_H0), nullptr, gw, ngw, lane);
}

typedef short bf16x8_t __attribute__((ext_vector_type(8)));
DEV void unpack8(const u32x4 w, float (&f)[8]) {
    f[0] = __builtin_bit_cast(float, w.x << 16); f[1] = __builtin_bit_cast(float, w.x & 0xffff0000u); f[2] = __builtin_bit_cast(float, w.y << 16); f[3] = __builtin_bit_cast(float, w.y & 0xffff0000u);
    f[4] = __builtin_bit_cast(float, w.z << 16); f[5] = __builtin_bit_cast(float, w.z & 0xffff0000u); f[6] = __builtin_bit_cast(float, w.w << 16); f[7] = __builtin_bit_cast(float, w.w & 0xffff0000u);
}
DEV void xs_lora_phase(const bf16_t* H1, const float* mix, bf16_t* XS0, bf16_t* XS1, bf16_t* XS2, bf16_t* XS3,
                       const bf16_t* w1t, const bf16_t* a1t, float* LW, float* LA, int wave, int lane) {
    for (int tile = blockIdx.x; tile < M / 64; tile += gridDim.x) {
        const int m0 = tile * 64;
#pragma unroll 1
        for (int j = 0; j < 2; ++j) {
            const int c = 8 * lane + 512 * j;
            float mx[4][8];
#pragma unroll
            for (int n = 0; n < 4; ++n) { const f32x4 m0v = *(const f32x4*)(mix + n * DM + c), m1v = *(const f32x4*)(mix + n * DM + c + 4);
                mx[n][0] = m0v.x; mx[n][1] = m0v.y; mx[n][2] = m0v.z; mx[n][3] = m0v.w; mx[n][4] = m1v.x; mx[n][5] = m1v.y; mx[n][6] = m1v.z; mx[n][7] = m1v.w; }
#pragma unroll 1
            for (int i = 0; i < 8; ++i) {
                const int m = m0 + 8 * wave + i;
                float h[8], p[8];
                unpack8(*(const u32x4*)(H1 + (size_t)m * DM + c), h);
                if ((m % SEQ) != 0) unpack8(*(const u32x4*)(H1 + (size_t)(m - 1) * DM + c), p);
                else {
#pragma unroll
                    for (int e = 0; e < 8; ++e) p[e] = 0.f;
                }
#pragma unroll
                for (int n = 0; n < 4; ++n) {
                    float o[8];
#pragma unroll
                    for (int e = 0; e < 8; ++e) o[e] = h[e] + (p[e] - h[e]) * mx[n][e];
                    u32x4 w; w.x = pk2(o[0], o[1]); w.y = pk2(o[2], o[3]); w.z = pk2(o[4], o[5]); w.w = pk2(o[6], o[7]);
                    bf16_t* dst = (n == 0) ? XS0 : (n == 1) ? XS1 : (n == 2) ? XS2 : XS3;
                    *(u32x4*)(dst + (size_t)m * DM + c) = w;
                }
            }
        }
        {
            const int mt = wave & 3, mat = wave >> 2, fr = lane & 15, g = lane >> 4;
            const int m = m0 + 16 * mt + fr;
            const bool has_prev = (m % SEQ) != 0;
            const bf16_t* hrow = H1 + (size_t)m * DM; const bf16_t* prow = H1 + (size_t)(m - (has_prev ? 1 : 0)) * DM;
            const float* mxp = mix + (4 + mat) * DM;
            const bf16_t* wt = mat ? a1t : w1t;
            f32x4 acc[4];
#pragma unroll
            for (int nt = 0; nt < 4; ++nt) acc[nt] = (f32x4){0.f, 0.f, 0.f, 0.f};
#pragma unroll 2
            for (int s = 0; s < 32; ++s) {
                const int k0 = 32 * s + 8 * g;
                float h[8], p[8];
                unpack8(*(const u32x4*)(hrow + k0), h); unpack8(*(const u32x4*)(prow + k0), p);
                const f32x4 m0v = *(const f32x4*)(mxp + k0), m1v = *(const f32x4*)(mxp + k0 + 4);
                const float mxv[8] = {m0v.x, m0v.y, m0v.z, m0v.w, m1v.x, m1v.y, m1v.z, m1v.w};
                float o[8];
#pragma unroll
                for (int e = 0; e < 8; ++e) { const float pe = has_prev ? p[e] : 0.f; o[e] = h[e] + (pe - h[e]) * mxv[e]; }
                u32x4 aw; aw.x = pk2(o[0], o[1]); aw.y = pk2(o[2], o[3]); aw.z = pk2(o[4], o[5]); aw.w = pk2(o[6], o[7]);
                const bf16x8_t af = __builtin_bit_cast(bf16x8_t, aw);
#pragma unroll
                for (int nt = 0; nt < 4; ++nt) {
                    const bf16x8_t bfr = *(const bf16x8_t*)(wt + (size_t)(16 * nt + fr) * DM + k0);
                    acc[nt] = __builtin_amdgcn_mfma_f32_16x16x32_bf16(af, bfr, acc[nt], 0, 0, 0);
                }
            }
            float* dst = mat ? LA : LW;
#pragma unroll
            for (int nt = 0; nt < 4; ++nt)
#pragma unroll
                for (int r = 0; r < 4; ++r) {
                    const float v = acc[nt][r];
                    dst[(size_t)(m0 + 16 * mt + 4 * g + r) * LORA + 16 * nt + fr] = mat ? v : tanhf(v);
                }
        }
    }
}
__global__ void __launch_bounds__(NTHREADS, 2) fwd_kernel(Args args) {
    extern __shared__ __attribute__((aligned(16))) unsigned char lds_raw[];
    LAS unsigned char* lds = (LAS unsigned char*)lds_raw;
    const int tid = threadIdx.x, lane = tid & 63, wave = __builtin_amdgcn_readfirstlane(tid >> 6);
    const int G = gridDim.x; const int gw = blockIdx.x * NWAVES + wave, ngw = G * NWAVES;
    unsigned char* ws = args.ws;
    unsigned* ctl = (unsigned*)(ws + WS_CTL);
    volatile LAS unsigned* MISC = (volatile LAS unsigned*)(lds + LDS_BYTES - 64);
    if (tid < 16) MISC[tid] = 0u;
    __syncthreads();
    XcdBarrier bar; bar.bar = ctl + CW_BAR; bar.x = 0; bar.st = nullptr;
    const int lo = args.ph_lo, hi = args.ph_hi;
    if (hi - lo > 1) bar = xcd_barrier_post(ctl + CW_BAR, MISC + 8);
#define IN(k) (lo <= (k) && (k) < hi)
#define SEAM(k) do { if (IN(k) && IN((k) + 1)) xcd_barrier(bar); } while (0)

    const float* x = args.in[I_X]; float* out = args.out;
    bf16_t* H0 = (bf16_t*)(ws + WS_H0); bf16_t* L0 = (bf16_t*)(ws + WS_L0); bf16_t* H1 = (bf16_t*)(ws + WS_H1);
    bf16_t* Qb = (bf16_t*)(ws + WS_Q); bf16_t* Kb = (bf16_t*)(ws + WS_K); bf16_t* Vb = (bf16_t*)(ws + WS_V);
    bf16_t* Gb = (bf16_t*)(ws + WS_G); bf16_t* OG = (bf16_t*)(ws + WS_OG);
    bf16_t* XS0 = (bf16_t*)out; bf16_t* XS1 = (bf16_t*)out + (size_t)M * DM; bf16_t* XS2 = (bf16_t*)(ws + WS_XS2); bf16_t* XS3 = (bf16_t*)(ws + WS_XS3);
    float* KM = (float*)(ws + WS_KM); float* LW = (float*)(ws + WS_LW); float* LA = (float*)(ws + WS_LA);
    const pg8::bf16_t* win0 = (const pg8::bf16_t*)(ws + WS_WIN0); const pg8::bf16_t* wout0 = (const pg8::bf16_t*)(ws + WS_WOUT0);
    const pg8::bf16_t* win1 = (const pg8::bf16_t*)(ws + WS_WIN1); const pg8::bf16_t* wout1 = (const pg8::bf16_t*)(ws + WS_WOUT1);

    if (IN(0)) { p0_prologue(lds, args, ws, gw, ngw, wave, lane); } SEAM(0);
    if (IN(1)) {
        pg8::Gemm g{H0, win0, M, 4 * DM, DM, nullptr, nullptr, nullptr, 0}; pg8::StaticOrder S; S.init(M, 4 * DM, G, (int)blockIdx.x);
        pg8::EpiBf16<0> E{Qb, DM, nullptr, DM, (size_t)M * DM, 1.f};
        pg8::gemm_phase<pg8::EpiBf16<0>, pg8::StaticOrder, true, true>(lds, g, S, E);
    } SEAM(1);
    if (IN(2)) { kmean_naive(Kb, KM, gw, ngw, lane); } SEAM(2);
    if (IN(3)) { moba_naive(Qb, Kb, Vb, Gb, KM, OG, gw, ngw, lane); } SEAM(3);
    if (IN(4)) {
        pg8::Gemm g{OG, wout0, M, DM, DM, nullptr, nullptr, nullptr, 0}; pg8::StaticOrder S; S.init(M, DM, G, (int)blockIdx.x);
        pg8::EpiRes E{x, nullptr, L0, out};
        pg8::gemm_phase<pg8::EpiRes, pg8::StaticOrder, false, true>(lds, g, S, E);
    } SEAM(4);
    if (IN(5)) { rms_rows<true>(out, args.in[I_RNG], H1, nullptr, gw, ngw, lane); } SEAM(5);
    if (IN(6)) { xs_lora_phase(H1, args.in[I_RMIX], XS0, XS1, XS2, XS3, (const bf16_t*)(ws + WS_W1T), (const bf16_t*)(ws + WS_A1T), LW, LA, wave, lane); } SEAM(6);
    if (IN(7)) {
        pg8::Gemm g{XS0, win1, M, 4 * DM, DM, XS1, XS2, XS3, 1}; pg8::StaticOrder S; S.init(M, 4 * DM, G, (int)blockIdx.x);
        pg8::EpiBf16<0> E{Qb, DM, nullptr, DM, (size_t)M * DM, 1.f};
        pg8::gemm_phase<pg8::EpiBf16<0>, pg8::StaticOrder, true, true>(lds, g, S, E);
    } SEAM(7);
    if (IN(8)) { rwkv_naive(lds, args, Qb, Kb, Vb, Gb, LW, LA, OG); } SEAM(8);
    if (IN(9)) {
        pg8::Gemm g{OG, wout1, M, DM, DM, nullptr, nullptr, nullptr, 0}; pg8::StaticOrder S; S.init(M, DM, G, (int)blockIdx.x);
        pg8::EpiRes E{x, L0, nullptr, out};
        pg8::gemm_phase<pg8::EpiRes, pg8::StaticOrder, false, true>(lds, g, S, E);
    } SEAM(9);
    if (IN(10)) { rms_rows<false>(out, args.in[I_FNG], nullptr, out, gw, ngw, lane); }
#undef IN
#undef SEAM
}

extern "C" void kernel_launch(void* const* d_in, const int* in_sizes, int n_in, void* d_out, int out_size, void* d_ws, size_t ws_size, hipStream_t stream) {
    static int grid = 0;
    if (grid == 0) {
        if (n_in != 20 || in_sizes[0] != M * DM || out_size != M * DM || ws_size < WS_END) { fprintf(stderr, "kernel_launch: unexpected shapes (n_in %d, in0 %d, out %d, ws %zu)\n", n_in, n_in > 0 ? in_sizes[0] : -1, out_size, ws_size); grid = -1; return; }
        int dev = 0, cus = 0, per_cu = 0;
        if (hipGetDevice(&dev) != hipSuccess || hipDeviceGetAttribute(&cus, hipDeviceAttributeMultiprocessorCount, dev) != hipSuccess) { grid = -1; return; }
        if (hipFuncSetAttribute((const void*)fwd_kernel, hipFuncAttributeMaxDynamicSharedMemorySize, LDS_BYTES) != hipSuccess) { fprintf(stderr, "kernel_launch: hipFuncSetAttribute failed\n"); grid = -1; return; }
        if (hipOccupancyMaxActiveBlocksPerMultiprocessor(&per_cu, (const void*)fwd_kernel, NTHREADS, LDS_BYTES) != hipSuccess || per_cu < 1) { fprintf(stderr, "kernel_launch: occupancy query says %d blocks per CU\n", per_cu); per_cu = 1; }
        (void)hipGetLastError();
        grid = cus;
    }
    if (grid < 0) return;
    (void)hipMemsetAsync((char*)d_ws + WS_CTL, 0, CTL_ZERO_BYTES, stream);
    Args a{};
    for (int i = 0; i < 20; ++i) a.in[i] = (const float*)d_in[i];
    a.out = (float*)d_out; a.ws = (unsigned char*)d_ws;
    if (MK_ONE_LAUNCH) {
        a.ph_lo = 0; a.ph_hi = N_PHASES;
        hipLaunchKernelGGL(fwd_kernel, dim3(grid), dim3(NTHREADS), LDS_BYTES, stream, a);
    } else {
        for (int p = 0; p < N_PHASES; ++p) { a.ph_lo = p; a.ph_hi = p + 1; hipLaunchKernelGGL(fwd_kernel, dim3(grid), dim3(NTHREADS), LDS_BYTES, stream, a); }
    }
}
```

```cpp
#include <hip/hip_runtime.h>
#include <cstdio>
#include <cstdint>
#include <cmath>

#define DEV __device__ __forceinline__
#define LAS __attribute__((address_space(3)))
#define GAS __attribute__((address_space(1)))

typedef unsigned short bf16_t;
typedef float f32x4 __attribute__((ext_vector_type(4)));
typedef float f32x2 __attribute__((ext_vector_type(2)));
typedef unsigned u32x4 __attribute__((ext_vector_type(4)));
typedef unsigned u32x2 __attribute__((ext_vector_type(2)));

constexpr int BATCH = 2, SEQ = 8192, DM = 1024, NH = 16, HD = 64, M = BATCH * SEQ;
constexpr int MBLK = 256, NBLK = SEQ / MBLK, TOPK = 3, LORA = 64;
constexpr float NORM_EPS = 1e-6f, LNX_EPS = 64e-5f;

constexpr int NWAVES = 8, NTHREADS = NWAVES * 64;
constexpr int N_PHASES = 13;
#ifndef MK_ONE_LAUNCH
#define MK_ONE_LAUNCH 1
#endif
constexpr int LDS_BYTES = 147456;

constexpr size_t MiB = 1u << 20;
constexpr size_t WS_CTL = 0, CTL_ZERO_BYTES = 1 * MiB;
constexpr size_t WS_KM = 1 * MiB;
constexpr size_t WS_LW = 2 * MiB, WS_LA = 4 * MiB;
constexpr size_t WS_BON = 6 * MiB;
constexpr size_t WS_WIN0 = 10 * MiB, WS_WOUT0 = 18 * MiB, WS_WIN1 = 20 * MiB, WS_WOUT1 = 28 * MiB;
constexpr size_t WS_W1T = 30 * MiB, WS_A1T = 30 * MiB + 128 * 1024;
constexpr size_t WS_W2T = 30 * MiB + 256 * 1024, WS_A2T = 30 * MiB + 384 * 1024;
constexpr size_t WS_H0 = 32 * MiB, WS_L0 = 32 * MiB;
constexpr size_t WS_Q = 64 * MiB, WS_K = 96 * MiB, WS_V = 128 * MiB, WS_G = 160 * MiB;
constexpr size_t WS_H1 = 64 * MiB;
constexpr size_t WS_OG = 192 * MiB;
constexpr size_t WS_XS2 = 192 * MiB, WS_XS3 = 224 * MiB;
constexpr size_t WS_PT = 192 * MiB, WS_GG = 224 * MiB;
constexpr size_t WS_END = 256 * MiB;
constexpr int CW_BAR = 4096;

DEV float bf2f(unsigned short u) { return __builtin_bit_cast(float, (unsigned)u << 16); }
DEV unsigned f2bf(float f) { unsigned u = __builtin_bit_cast(unsigned, f); return (u + 0x7fffu + ((u >> 16) & 1u)) >> 16; }
DEV unsigned pk2(float lo, float hi) { return f2bf(lo) | (f2bf(hi) << 16); }
DEV float wave_sum(float v) {
#pragma unroll
    for (int o = 1; o < 64; o <<= 1) v += __shfl_xor(v, o);
    return v;
}
DEV float wave_max(float v) {
#pragma unroll
    for (int o = 1; o < 64; o <<= 1) v = fmaxf(v, __shfl_xor(v, o));
    return v;
}
DEV float silu_f(float x) { return x / (1.f + __expf(-x)); }

#define XB_TMO      128
#define XB_XCNT(j)  (256  + 64 * (j))
#define XB_XSUB(j)  (1280 + 64 * (j))
#define XB_XGEN(j)  (2304 + 64 * (j))
#define XB_TOP      3328
#define XB_TOPGEN   3392
#define XCD_BAR_WORDS 3456
#define XB_SPIN_CAP (1u << 20)
DEV unsigned xb_ld(unsigned* p)              { return __hip_atomic_load(p, __ATOMIC_RELAXED, __HIP_MEMORY_SCOPE_AGENT); }
DEV unsigned xb_add(unsigned* p, unsigned v) { return __hip_atomic_fetch_add(p, v, __ATOMIC_RELAXED, __HIP_MEMORY_SCOPE_AGENT); }
DEV unsigned xb_xcc_id() { return (unsigned)__builtin_amdgcn_s_getreg((3 << 11) | 20) & 0xFu; }
#define XB_SPIN(cond, bar) do { unsigned _sp = 0; while (cond) { __builtin_amdgcn_s_sleep(1); \
    if ((++_sp & 255u) == 0u) { if (xb_ld(&(bar)[XB_TMO])) break; if (_sp > XB_SPIN_CAP) { atomicAdd(&(bar)[XB_TMO], 1u); break; } } } } while (0)
struct XcdBarrier { unsigned* bar; unsigned x; volatile LAS unsigned* st; };
DEV XcdBarrier xcd_barrier_post(unsigned* bar, volatile LAS unsigned* st) {
    XcdBarrier b; b.bar = bar; b.x = xb_xcc_id(); b.st = st;
    if (threadIdx.x == 0) (void)xb_add(&bar[XB_XCNT(b.x)], 1u);
    return b;
}
DEV void xcd_barrier_complete(unsigned* bar, unsigned x, unsigned& nloc, unsigned& nx) {
    const unsigned G = gridDim.x * gridDim.y * gridDim.z;
    unsigned sum, cnt, mine, sp = 0u;
    for (;;) {
        sum = 0u; cnt = 0u; mine = 0u;
#pragma unroll
        for (unsigned j = 0; j < 16; ++j) { const unsigned c = xb_ld(&bar[XB_XCNT(j)]); sum += c; cnt += (c > 0u) ? 1u : 0u; mine = (j == x) ? c : mine; }
        if (sum == G) break;
        __builtin_amdgcn_s_sleep(1);
        if ((++sp & 255u) == 0u) { if (xb_ld(&bar[XB_TMO])) break; if (sp > XB_SPIN_CAP) { atomicAdd(&bar[XB_TMO], 1u); break; } }
    }
    nloc = mine > 0u ? mine : 1u; nx = cnt > 0u ? cnt : 1u;
}
DEV void xcd_barrier(const XcdBarrier& b) {
    asm volatile("s_waitcnt vmcnt(0)" ::: "memory");
    __syncthreads();
    if (threadIdx.x == 0) {
        unsigned* bar = b.bar;
        __builtin_amdgcn_s_waitcnt(0);
        unsigned nloc = b.st[0], nx = b.st[1];
        if (nloc == 0u) { xcd_barrier_complete(bar, b.x, nloc, nx); b.st[0] = nloc; b.st[1] = nx; }
        const unsigned old = xb_add(&bar[XB_XSUB(b.x)], 1u);
        const unsigned gen = old / nloc;
        if (old + 1u == (gen + 1u) * nloc) {
            __builtin_amdgcn_fence(__ATOMIC_RELEASE, "agent");
            asm volatile("s_waitcnt vmcnt(0)" ::: "memory");
            const unsigned og = xb_add(&bar[XB_TOP], 1u);
            const unsigned tg = og / nx;
            if (og + 1u == (tg + 1u) * nx) xb_add(&bar[XB_TOPGEN], 1u);
            else XB_SPIN(xb_ld(&bar[XB_TOPGEN]) == tg, bar);
            __builtin_amdgcn_fence(__ATOMIC_ACQUIRE, "agent");
            xb_add(&bar[XB_XGEN(b.x)], 1u);
            asm volatile("s_waitcnt vmcnt(0)" ::: "memory");
        } else {
            XB_SPIN(xb_ld(&bar[XB_XGEN(b.x)]) == gen, bar);
            __builtin_amdgcn_fence(__ATOMIC_ACQUIRE, "agent");
            asm volatile("s_waitcnt vmcnt(0)" ::: "memory");
        }
    }
    __syncthreads();
}

struct Args { const float* in[20]; float* out; unsigned char* ws; int ph_lo, ph_hi; };
enum { I_X = 0, I_MNG, I_MWIN, I_MWOUT, I_RNG, I_RMIX, I_RWIN, I_W0, I_W1, I_W2, I_A0, I_A1, I_A2, I_KK, I_KA, I_RK, I_LNG, I_LNB, I_RWOUT, I_FNG };

namespace pg8 {
#define PG8_LAS __attribute__((address_space(3)))
typedef unsigned short bf16_t;
typedef short bf16x8 __attribute__((ext_vector_type(8)));
typedef float f32x4 __attribute__((ext_vector_type(4)));
typedef unsigned u32x4 __attribute__((ext_vector_type(4)));
constexpr int BM = 256, BK = 64, HALF = 128, HTB = HALF * BK * 2  , STAGE_BYTES = 8 * HTB, NXCD = 8, WGM = 8;

__host__ __device__ __forceinline__ int lds_byte(int r, int c) { const int st = (r >> 4) * 2 + (c >> 5), rr = r & 15, cc = c & 31, ob = rr * 64 + cc * 2; return st * 1024 + (ob ^ (((ob >> 9) & 1) << 5)); }
__host__ __device__ __forceinline__ void stage_rc(int b, int& R, int& C) { const int st = b / 1024, sb = b % 1024, swz = sb ^ (((sb >> 9) & 1) << 5); R = (st >> 1) * 16 + swz / 64; C = (st & 1) * 32 + (swz % 64) / 2; }
__host__ __device__ __forceinline__ int perm32(int rho) { const int n = rho >> 4, i = rho & 15; return 8 * (i >> 2) + 4 * n + (i & 3); }

struct Unit { int pm, pn; };
struct Gemm { const bf16_t* A; const bf16_t* Bt; int M, N, K; const bf16_t* A1; const bf16_t* A2; const bf16_t* A3; int grouped; };
__device__ __forceinline__ const char* a_base(const Gemm& g, const Unit& u, size_t tstep) { const bf16_t* p = g.A; if (g.grouped) { const int s = u.pn >> 2; p = (s == 0) ? g.A : (s == 1) ? g.A1 : (s == 2) ? g.A2 : g.A3; } return (const char*)p + (size_t)u.pm * tstep; }

struct StaticOrder {
    int nM, nN, nwg, G, c;
    __host__ __device__ void init(int M, int N, int G_, int c_) { nM = M / BM; nN = N / BM; nwg = nM * nN; G = G_; c = c_; }
    __host__ __device__ bool next(int i, Unit& u) const {
        const long L = (long)i * G + c; if (L >= nwg) return false;
        int wgid = (int)L; { const int q = nwg / NXCD, r = nwg % NXCD, xcd = wgid % NXCD, off = wgid / NXCD; wgid = (xcd < r ? xcd * (q + 1) : r * (q + 1) + (xcd - r) * q) + off; }
        const int nig = WGM * nN, gid = wgid / nig, fm = gid * WGM, gsz = (nM - fm) < WGM ? (nM - fm) : WGM;
        u.pm = fm + ((wgid % nig) % gsz); u.pn = (wgid % nig) / gsz; return true;
    }
    __device__ __forceinline__ void a_ready(const Unit&) const {}
    __device__ __forceinline__ void done(const Unit&) const {}
};

__device__ __forceinline__ unsigned cvt_pk_bf16(float lo, float hi) { unsigned r; asm volatile("v_cvt_pk_bf16_f32 %0, %1, %2" : "=v"(r) : "v"(lo), "v"(hi)); return r; }
typedef float f32x2 __attribute__((ext_vector_type(2)));
__device__ __forceinline__ f32x2 gelu_pk(f32x2 v) {
    const f32x2 av = __builtin_elementwise_abs(v), d = av * 0.2316418882f + 1.0f;
    f32x2 t; t.x = __builtin_amdgcn_rcpf(d.x); t.y = __builtin_amdgcn_rcpf(d.y);
    f32x2 q = t * 0.5307027145f + (-0.7265760135f); q = q * t + 0.7107068705f; q = q * t + (-0.142248368f); q = q * t + 0.127414796f; q = q * t;
    const f32x2 s = (v * v) * (-0.72134752044f);
    f32x2 e; e.x = __builtin_amdgcn_exp2f(s.x); e.y = __builtin_amdgcn_exp2f(s.y);
    const f32x2 m = v * (q * e), r = v - m;
    f32x2 o; o.x = v.x < 0.f ? m.x : r.x; o.y = v.y < 0.f ? m.y : r.y; return o;
}

template <int ACT  > struct EpiBf16 {
    static constexpr bool PERM = true, AFTER_DRAIN = false; static_assert(ACT == 0 || ACT == 1, "EpiBf16: ACT is 0 (none) or 1 (gelu_pk)");
    bf16_t* O; int ldc; const float* bias; int split_cols; size_t split_stride; float scale0;
    __device__ __forceinline__ void operator()(const f32x4 (&acc)[2][2][4][2], const Unit& u, int wr, int wc, int fr, int fq) const {
        const int row0 = u.pm * BM + wr * 64 + fr; int colt = u.pn * BM; bf16_t* base = O;
        float sc = 1.f; if (split_cols) { const int t = colt / split_cols; base += (size_t)t * split_stride; colt -= t * split_cols; if (t == 0) sc = scale0; }
        const int col0 = colt + wc * 32 + 8 * fq, bcol0 = u.pn * BM + wc * 32 + 8 * fq;
        f32x4 bv[2][2];
#pragma unroll
        for (int bj = 0; bj < 2; ++bj)
#pragma unroll
            for (int n = 0; n < 2; ++n) bv[bj][n] = bias ? *(const f32x4*)(bias + bcol0 + bj * HALF + 4 * n) : (f32x4){0.f, 0.f, 0.f, 0.f};
#pragma unroll
        for (int ai = 0; ai < 2; ++ai)
#pragma unroll
            for (int m = 0; m < 4; ++m) { bf16_t* rowp = base + (size_t)(row0 + ai * HALF + m * 16) * ldc + col0;
#pragma unroll
                for (int bj = 0; bj < 2; ++bj) { f32x4 v0 = acc[ai][bj][m][0] + bv[bj][0], v1 = acc[ai][bj][m][1] + bv[bj][1];
                    if (ACT == 1) { f32x2 a = gelu_pk((f32x2){v0[0], v0[1]}), b = gelu_pk((f32x2){v0[2], v0[3]}), c = gelu_pk((f32x2){v1[0], v1[1]}), d = gelu_pk((f32x2){v1[2], v1[3]});
                        v0 = (f32x4){a.x, a.y, b.x, b.y}; v1 = (f32x4){c.x, c.y, d.x, d.y}; }
                    v0 = v0 * sc; v1 = v1 * sc; u32x4 w; w.x = cvt_pk_bf16(v0[0], v0[1]); w.y = cvt_pk_bf16(v0[2], v0[3]); w.z = cvt_pk_bf16(v1[0], v1[1]); w.w = cvt_pk_bf16(v1[2], v1[3]);
                    *(u32x4*)(rowp + bj * HALF) = w; } }
    }
};

struct EpiRes {
    static constexpr bool PERM = false, AFTER_DRAIN = false;
    const float* base; const bf16_t* l0in; bf16_t* l0out; float* out;
    __device__ __forceinline__ void operator()(const f32x4 (&acc)[2][2][4][2], const Unit& u, int wr, int wc, int fr, int fq) const {
        typedef unsigned u32x2v __attribute__((ext_vector_type(2)));
        const int col0 = u.pn * BM + wc * 32 + 4 * fq;
#pragma unroll
        for (int ai = 0; ai < 2; ++ai)
#pragma unroll
            for (int m = 0; m < 4; ++m) { const size_t roff = (size_t)(u.pm * BM + ai * HALF + wr * 64 + m * 16 + fr) * 1024 + col0;
#pragma unroll
                for (int bj = 0; bj < 2; ++bj)
#pragma unroll
                    for (int n = 0; n < 2; ++n) { const size_t off = roff + bj * HALF + n * 16; const f32x4 v = acc[ai][bj][m][n];
                        f32x4 b = *(const f32x4*)(base + off);
                        if (l0in) { const u32x2v w = *(const u32x2v*)(l0in + off);
                            b[0] += __builtin_bit_cast(float, w.x << 16); b[1] += __builtin_bit_cast(float, w.x & 0xffff0000u); b[2] += __builtin_bit_cast(float, w.y << 16); b[3] += __builtin_bit_cast(float, w.y & 0xffff0000u); }
                        if (l0out) { u32x2v w; w.x = cvt_pk_bf16(v[0], v[1]); w.y = cvt_pk_bf16(v[2], v[3]); *(u32x2v*)(l0out + off) = w; }
                        *(f32x4*)(out + off) = b + v; } }
    }
};

template <class Epi, class Sched, bool ALIGN_EPI = false, bool SP2 = false>
__device__ __forceinline__ void gemm_phase(PG8_LAS unsigned char* lds, const Gemm g, const Sched& S, const Epi& E) {
    const int tid = threadIdx.x, wid = __builtin_amdgcn_readfirstlane(tid >> 6), lane = tid & 63, wr = wid >> 2, wc = wid & 3, fr = lane & 15, fq = lane >> 4;
    const int K = g.K, nt = K / BK;
    unsigned voffA[2], voffB[2];
#pragma unroll
    for (int i = 0; i < 2; ++i) { int R, C; stage_rc(tid * 16 + i * 8192, R, C); const int Rb = Epi::PERM ? ((R & ~31) + perm32(R & 31)) : R;
        voffA[i] = (unsigned)(R * K + C) * 2u; voffB[i] = (unsigned)(Rb * K + C) * 2u; }
    const size_t kstep = (size_t)(BK * 2);
    const size_t hstep = (size_t)HALF * K * 2;
    const size_t tstep = 2 * hstep;
    const unsigned ldsw = (unsigned)wid * 1024u;
    const int aoff = lds_byte(wr * 64 + fr, fq * 8), boff = lds_byte(wc * 32 + fr, fq * 8);
#define PG8_SA(b, h) (((b) * 2 + (h)) * HTB)
#define PG8_SB(b, h) ((4 + (b) * 2 + (h)) * HTB)
#define PG8_STAGE(bufoff, gbase, voff) do { _Pragma("unroll") for (int _i = 0; _i < 2; ++_i) \
        __builtin_amdgcn_global_load_lds((const unsigned*)((const char*)(gbase) + (voff)[_i]), (PG8_LAS unsigned*)(lds + (bufoff) + ldsw + _i * 8192), 16, 0, 0); } while (0)
#define PG8_LDA(dst, b, h) do { _Pragma("unroll") for (int m = 0; m < 4; ++m) _Pragma("unroll") for (int k = 0; k < 2; ++k) dst[m][k] = *(const PG8_LAS bf16x8*)(lds + PG8_SA(b, h) + aoff + m * 2048 + k * 1024); } while (0)
#define PG8_LDB(dst, b, h) do { _Pragma("unroll") for (int n = 0; n < 2; ++n) _Pragma("unroll") for (int k = 0; k < 2; ++k) dst[n][k] = *(const PG8_LAS bf16x8*)(lds + PG8_SB(b, h) + boff + n * 2048 + k * 1024); } while (0)
#define PG8_MMA(ai, bj, At, Bt) do { __builtin_amdgcn_s_setprio(1); _Pragma("unroll") for (int m = 0; m < 4; ++m) _Pragma("unroll") for (int n = 0; n < 2; ++n) _Pragma("unroll") for (int k = 0; k < 2; ++k) \
        acc[ai][bj][m][n] = __builtin_amdgcn_mfma_f32_16x16x32_bf16(Bt[n][k], At[m][k], acc[ai][bj][m][n], 0, 0, 0); __builtin_amdgcn_s_setprio(0); } while (0)
#define PG8_WAIT_V(n) asm volatile("s_waitcnt vmcnt(" #n ")" ::: "memory")
#define PG8_WAIT_L(n) asm volatile("s_waitcnt lgkmcnt(" #n ")" ::: "memory")
#define PG8_BAR __builtin_amdgcn_s_barrier()
#define PG8_SCHED __builtin_amdgcn_sched_barrier(0)
    Unit cur, nxt; int ui = 0;
    if (!S.next(0, cur)) return;
    f32x4 acc[2][2][4][2];
#pragma unroll
    for (int a = 0; a < 2; ++a)
#pragma unroll
        for (int b = 0; b < 2; ++b)
#pragma unroll
            for (int m = 0; m < 4; ++m)
#pragma unroll
                for (int n = 0; n < 2; ++n) acc[a][b][m][n] = (f32x4){0.f, 0.f, 0.f, 0.f};
    bf16x8 At[4][2], B0[2][2], B1[2][2];
    const char* cA = a_base(g, cur, tstep); const char* cB = (const char*)g.Bt + (size_t)cur.pn * tstep;
    S.a_ready(cur);
    if constexpr (SP2) {
        PG8_STAGE(PG8_SB(0, 0), cB, voffB); PG8_STAGE(PG8_SB(0, 1), cB + hstep, voffB); PG8_STAGE(PG8_SA(0, 0), cA, voffA); PG8_STAGE(PG8_SA(0, 1), cA + hstep, voffA);
        if (wr == 1) PG8_BAR;
        PG8_WAIT_V(2); PG8_BAR;
        PG8_STAGE(PG8_SB(1, 0), cB + kstep, voffB); PG8_STAGE(PG8_SA(1, 0), cA + kstep, voffA); PG8_STAGE(PG8_SB(1, 1), cB + hstep + kstep, voffB);
        PG8_WAIT_V(6); PG8_BAR;
    } else {
        PG8_STAGE(PG8_SB(0, 0), cB, voffB); PG8_STAGE(PG8_SA(0, 0), cA, voffA); PG8_STAGE(PG8_SB(0, 1), cB + hstep, voffB); PG8_STAGE(PG8_SA(0, 1), cA + hstep, voffA);
        if (wr == 1) PG8_BAR;
        PG8_WAIT_V(4); PG8_BAR;
        PG8_STAGE(PG8_SB(1, 0), cB + kstep, voffB); PG8_STAGE(PG8_SA(1, 0), cA + kstep, voffA); PG8_STAGE(PG8_SB(1, 1), cB + hstep + kstep, voffB);
        PG8_WAIT_V(6); PG8_BAR;
    }
    for (;;) {
        const bool has_next = S.next(ui + 1, nxt);
        const char* nA = has_next ? a_base(g, nxt, tstep) : cA; const char* nB = has_next ? (const char*)g.Bt + (size_t)nxt.pn * tstep : cB;
        for (int t = 0; t < nt; t += 2) {
            const bool last = (t == nt - 2);
            const char* a1 = cA + (size_t)(t + 1) * kstep;
            const char* a2 = last ? nA : cA + (size_t)(t + 2) * kstep; const char* b2 = last ? nB : cB + (size_t)(t + 2) * kstep;
            const char* a3 = a2 + kstep; const char* b3 = b2 + kstep;
            if (last && has_next) S.a_ready(nxt);
            if constexpr (SP2) {
            PG8_LDB(B0, 0, 0); PG8_LDB(B1, 0, 1); PG8_SCHED; PG8_LDA(At, 0, 0); PG8_STAGE(PG8_SA(1, 1), a1 + hstep, voffA);
            PG8_WAIT_V(8); PG8_WAIT_L(0); PG8_BAR; PG8_MMA(0, 0, At, B0); PG8_MMA(0, 1, At, B1); PG8_BAR; PG8_SCHED;
            PG8_LDA(At, 0, 1); PG8_STAGE(PG8_SB(0, 0), b2, voffB); PG8_STAGE(PG8_SB(0, 1), b2 + hstep, voffB); PG8_STAGE(PG8_SA(0, 0), a2, voffA);
            PG8_WAIT_V(8); PG8_WAIT_L(0); PG8_BAR; PG8_MMA(1, 0, At, B0); PG8_MMA(1, 1, At, B1); PG8_BAR; PG8_SCHED;
            PG8_LDB(B0, 1, 0); PG8_LDB(B1, 1, 1); PG8_SCHED; PG8_LDA(At, 1, 0); PG8_STAGE(PG8_SA(0, 1), a2 + hstep, voffA);
            PG8_WAIT_V(8); PG8_WAIT_L(0); PG8_BAR; PG8_MMA(0, 0, At, B0); PG8_MMA(0, 1, At, B1); PG8_BAR; PG8_SCHED;
            PG8_LDA(At, 1, 1); PG8_STAGE(PG8_SB(1, 0), b3, voffB); PG8_STAGE(PG8_SB(1, 1), b3 + hstep, voffB); PG8_STAGE(PG8_SA(1, 0), a3, voffA);
            PG8_WAIT_V(8); PG8_WAIT_L(0); PG8_BAR; PG8_MMA(1, 0, At, B0); PG8_MMA(1, 1, At, B1); PG8_BAR; PG8_SCHED;
            } else {
            PG8_LDB(B0, 0, 0); PG8_SCHED; PG8_LDA(At, 0, 0); PG8_STAGE(PG8_SA(1, 1), a1 + hstep, voffA);
            PG8_WAIT_L(8); PG8_BAR; PG8_WAIT_L(0); PG8_MMA(0, 0, At, B0); PG8_BAR; PG8_SCHED;
            PG8_LDB(B1, 0, 1); PG8_STAGE(PG8_SB(0, 0), b2, voffB);
            PG8_BAR; PG8_WAIT_L(0); PG8_MMA(0, 1, At, B1); PG8_BAR;
            PG8_LDA(At, 0, 1); PG8_STAGE(PG8_SA(0, 0), a2, voffA);
            PG8_BAR; PG8_WAIT_L(0); PG8_MMA(1, 0, At, B0); PG8_BAR; PG8_SCHED;
            PG8_STAGE(PG8_SB(0, 1), b2 + hstep, voffB);
            PG8_WAIT_V(6); PG8_BAR; PG8_MMA(1, 1, At, B1); PG8_BAR;
            PG8_LDB(B0, 1, 0); PG8_SCHED; PG8_LDA(At, 1, 0); PG8_STAGE(PG8_SA(0, 1), a2 + hstep, voffA);
            PG8_WAIT_L(8); PG8_BAR; PG8_WAIT_L(0); PG8_MMA(0, 0, At, B0); PG8_BAR; PG8_SCHED;
            PG8_LDB(B1, 1, 1); PG8_STAGE(PG8_SB(1, 0), b3, voffB);
            PG8_BAR; PG8_WAIT_L(0); PG8_MMA(0, 1, At, B1); PG8_BAR;
            PG8_LDA(At, 1, 1); PG8_STAGE(PG8_SA(1, 0), a3, voffA);
            PG8_BAR; PG8_WAIT_L(0); PG8_MMA(1, 0, At, B0); PG8_BAR; PG8_SCHED;
            PG8_STAGE(PG8_SB(1, 1), b3 + hstep, voffB);
            PG8_WAIT_V(6); PG8_BAR; PG8_MMA(1, 1, At, B1); PG8_BAR;
            }
        }
        if constexpr (ALIGN_EPI) { if (wr == 0) PG8_BAR; }
        if constexpr (!Epi::AFTER_DRAIN) { E(acc, cur, wr, wc, fr, fq); S.done(cur); }
        if (!has_next) break;
#pragma unroll
        for (int a = 0; a < 2; ++a)
#pragma unroll
            for (int b = 0; b < 2; ++b)
#pragma unroll
                for (int m = 0; m < 4; ++m)
#pragma unroll
                    for (int n = 0; n < 2; ++n) acc[a][b][m][n] = (f32x4){0.f, 0.f, 0.f, 0.f};
        cur = nxt; cA = nA; cB = nB; ++ui;
        if constexpr (ALIGN_EPI) { if (wr == 1) PG8_BAR; }
    }
    PG8_WAIT_V(0);
    if constexpr (!ALIGN_EPI) { if (wr == 0) PG8_BAR; }
    PG8_BAR;
    if constexpr (Epi::AFTER_DRAIN) { E.fused(acc, cur, wr, wc, fr, fq, lds, wid, lane); S.done(cur); }
#undef PG8_SA
#undef PG8_SB
#undef PG8_STAGE
#undef PG8_LDA
#undef PG8_LDB
#undef PG8_MMA
#undef PG8_WAIT_V
#undef PG8_WAIT_L
#undef PG8_BAR
#undef PG8_SCHED
}
}
template <bool OUT_BF16>
DEV void rms_rows(const float* xin, const float* g, bf16_t* ob, float* of, int gw, int ngw, int lane) {
    for (int m = gw; m < M; m += ngw) {
        const f32x4* xr = (const f32x4*)(xin + (size_t)m * DM) + lane;
        f32x4 v[4]; float s = 0.f;
#pragma unroll
        for (int j = 0; j < 4; ++j) { v[j] = xr[64 * j]; s += (v[j].x * v[j].x + v[j].y * v[j].y) + (v[j].z * v[j].z + v[j].w * v[j].w); }
        const float rstd = 1.f / sqrtf(wave_sum(s) * (1.f / DM) + NORM_EPS);
#pragma unroll
        for (int j = 0; j < 4; ++j) {
            const f32x4 gv = *((const f32x4*)g + lane + 64 * j);
            const f32x4 o = v[j] * rstd * gv;
            if (OUT_BF16) { u32x2 w; w.x = pk2(o.x, o.y); w.y = pk2(o.z, o.w); *((u32x2*)(ob + (size_t)m * DM) + lane + 64 * j) = w; }
            else *((f32x4*)(of + (size_t)m * DM) + lane + 64 * j) = o;
        }
    }
}

DEV void kmean_naive(const bf16_t* Kb, float* KM, int gw, int ngw, int lane) {
    for (int it = gw; it < BATCH * NH * NBLK; it += ngw) {
        const int j = it % NBLK, h = (it / NBLK) % NH, b = it / (NBLK * NH);
        const bf16_t* kp = Kb + ((size_t)b * SEQ + (size_t)j * MBLK) * DM + h * HD + lane;
        float s = 0.f;
        for (int i = 0; i < MBLK; ++i) s += bf2f(kp[(size_t)i * DM]);
        KM[(size_t)it * HD + lane] = s * (1.f / MBLK);
    }
}

DEV void moba_naive(const bf16_t* Qb, const bf16_t* Kb, const bf16_t* Vb, const bf16_t* Gb, const float* KM, bf16_t* OG, int gw, int ngw, int lane) {
    for (int item = gw; item < M * NH; item += ngw) {
        const int t = item / NH, h = item % NH, b = t / SEQ, ts = t % SEQ, own = ts / MBLK;
        const float slope = exp2f(-0.5f * (float)(h + 1));
        const float qd = bf2f(Qb[(size_t)t * DM + h * HD + lane]);
        float myscore = -INFINITY;
        const float* kmp = KM + ((size_t)(b * NH + h) * NBLK) * HD + lane;
        for (int j = 0; j < own; ++j) { const float p = wave_sum(qd * kmp[(size_t)j * HD]); if (lane == j) myscore = p; }
        const int nsel = own < TOPK ? own : TOPK;
        int sel[4];
#pragma unroll
        for (int r = 0; r < TOPK; ++r) {
            const float mx = wave_max(myscore);
            const unsigned long long bal = __ballot(myscore == mx);
            const int sl = __builtin_amdgcn_readfirstlane((int)__builtin_ctzll(bal));
            sel[r] = sl; if (lane == sl) myscore = -INFINITY;
        }
        sel[3] = own;
        float q[64];
        {
            const u32x4* qp = (const u32x4*)(Qb + (size_t)t * DM + h * HD);
#pragma unroll
            for (int c = 0; c < 8; ++c) { const u32x4 w = qp[c];
                q[8 * c + 0] = bf2f(w.x & 0xffff); q[8 * c + 1] = bf2f(w.x >> 16); q[8 * c + 2] = bf2f(w.y & 0xffff); q[8 * c + 3] = bf2f(w.y >> 16);
                q[8 * c + 4] = bf2f(w.z & 0xffff); q[8 * c + 5] = bf2f(w.z >> 16); q[8 * c + 6] = bf2f(w.w & 0xffff); q[8 * c + 7] = bf2f(w.w >> 16); }
        }
        float sc[4][4]; float mx = -INFINITY;
#pragma unroll
        for (int s = 0; s < 4; ++s) {
            const bool valid = (s == 3) || (s < nsel);
#pragma unroll
            for (int i = 0; i < 4; ++i) sc[s][i] = -INFINITY;
            if (valid) {
                const int blk = sel[s];
#pragma unroll
                for (int i = 0; i < 4; ++i) {
                    const int pos = blk * MBLK + lane + 64 * i;
                    const u32x4* kp = (const u32x4*)(Kb + ((size_t)b * SEQ + pos) * DM + h * HD);
                    float d = 0.f;
#pragma unroll
                    for (int c = 0; c < 8; ++c) { const u32x4 w = kp[c];
                        d += q[8 * c + 0] * bf2f(w.x & 0xffff) + q[8 * c + 1] * bf2f(w.x >> 16) + q[8 * c + 2] * bf2f(w.y & 0xffff) + q[8 * c + 3] * bf2f(w.y >> 16)
                           + q[8 * c + 4] * bf2f(w.z & 0xffff) + q[8 * c + 5] * bf2f(w.z >> 16) + q[8 * c + 6] * bf2f(w.w & 0xffff) + q[8 * c + 7] * bf2f(w.w >> 16); }
                    float sv = d * 0.125f - slope * (float)(ts - pos);
                    if (s == 3 && pos > ts) sv = -INFINITY;
                    sc[s][i] = sv; mx = fmaxf(mx, sv);
                }
            }
        }
        mx = wave_max(mx);
        float l = 0.f;
#pragma unroll
        for (int s = 0; s < 4; ++s)
#pragma unroll
            for (int i = 0; i < 4; ++i) { const float p = __expf(sc[s][i] - mx); sc[s][i] = p; l += p; }
        l = wave_sum(l);
        float o = 0.f;
#pragma unroll
        for (int s = 0; s < 4; ++s) {
            const bool valid = (s == 3) || (s < nsel);
            if (valid) {
                const int blk = sel[s];
#pragma unroll
                for (int i = 0; i < 4; ++i) {
                    const bf16_t* vp = Vb + ((size_t)b * SEQ + (size_t)blk * MBLK + 64 * i) * DM + h * HD + lane;
                    const float pv = sc[s][i];
                    for (int ll = 0; ll < 64; ++ll) o += __shfl(pv, ll) * bf2f(vp[(size_t)ll * DM]);
                }
            }
        }
        const float gt = bf2f(Gb[(size_t)t * DM + h * HD + lane]);
        OG[(size_t)t * DM + h * HD + lane] = (bf16_t)f2bf(o / l * silu_f(gt));
    }
}


#define LDS_WAIT() asm volatile("s_waitcnt lgkmcnt(0)" ::: "memory")
__device__ __forceinline__ void p0_transpose_item(const float* W, int K, int N, bf16_t* WT, int row_off, LAS float* scr, int item, int lane) {
    const int nblk = N / 32, kb = item / nblk, nb = item % nblk, k0 = 64 * kb, n0 = 32 * nb;
#pragma unroll 8
    for (int i = 0; i < 32; ++i) { const int kk = 2 * i + (lane >> 5); scr[kk * 33 + (lane & 31)] = W[(size_t)(k0 + kk) * N + n0 + (lane & 31)]; }
    LDS_WAIT(); asm volatile("" ::: "memory");
    const int c = lane & 7;
#pragma unroll
    for (int j = 0; j < 4; ++j) { const int n = (lane >> 3) + 8 * j; const LAS float* s = scr + (8 * c) * 33 + n;
        u32x4 o; o.x = pk2(s[0 * 33], s[1 * 33]); o.y = pk2(s[2 * 33], s[3 * 33]); o.z = pk2(s[4 * 33], s[5 * 33]); o.w = pk2(s[6 * 33], s[7 * 33]);
        *(GAS u32x4*)(WT + (size_t)(row_off + n0 + n) * K + k0 + 8 * c) = o; }
    LDS_WAIT(); asm volatile("" ::: "memory");
}

DEV void p0_prologue(LAS unsigned char* lds, const Args& a, unsigned char* ws, int gw, int ngw, int wave, int lane) {
    LAS float* scr = (LAS float*)(lds + wave * 16384);
    constexpr int I_IN = (DM / 64) * (4 * DM / 32), I_SQ = (DM / 64) * (DM / 32), I_LO = (DM / 64) * (LORA / 32);
    constexpr int I_UP = (LORA / 64) * (DM / 32);
    constexpr int NITEMS = I_IN + I_SQ + 4 * I_SQ + I_SQ + 2 * I_LO + 2 * I_UP;
    bf16_t* win0 = (bf16_t*)(ws + WS_WIN0); bf16_t* wout0 = (bf16_t*)(ws + WS_WOUT0); bf16_t* win1 = (bf16_t*)(ws + WS_WIN1); bf16_t* wout1 = (bf16_t*)(ws + WS_WOUT1);
    bf16_t* w1t = (bf16_t*)(ws + WS_W1T); bf16_t* a1t = (bf16_t*)(ws + WS_A1T);
    for (int it = gw; it < NITEMS; it += ngw) {
        int r = it;
        if (r < I_IN) { p0_transpose_item(a.in[I_MWIN], DM, 4 * DM, win0, 0, scr, r, lane); continue; } r -= I_IN;
        if (r < I_SQ) { p0_transpose_item(a.in[I_MWOUT], DM, DM, wout0, 0, scr, r, lane); continue; } r -= I_SQ;
        if (r < 4 * I_SQ) { const int s = r / I_SQ; p0_transpose_item(a.in[I_RWIN] + (size_t)s * DM * DM, DM, DM, win1, s * DM, scr, r % I_SQ, lane); continue; } r -= 4 * I_SQ;
        if (r < I_SQ) { p0_transpose_item(a.in[I_RWOUT], DM, DM, wout1, 0, scr, r, lane); continue; } r -= I_SQ;
        if (r < I_LO) { p0_transpose_item(a.in[I_W1], DM, LORA, w1t, 0, scr, r, lane); continue; } r -= I_LO;
        if (r < I_LO) { p0_transpose_item(a.in[I_A1], DM, LORA, a1t, 0, scr, r, lane); continue; } r -= I_LO;
        if (r < I_UP) { p0_transpose_item(a.in[I_W2], LORA, DM, (bf16_t*)(ws + WS_W2T), 0, scr, r, lane); continue; } r -= I_UP;
        p0_transpose_item(a.in[I_A2], LORA, DM, (bf16_t*)(ws + WS_A2T), 0, scr, r, lane);
    }
    rms_rows<true>(a.in[I_X], a.in[I_MNG], (bf16_t*)(ws + WS_H0), nullptr, gw, ngw, lane);
}

typedef short bf16x8_t __attribute__((ext_vector_type(8)));
DEV void unpack8(const u32x4 w, float (&f)[8]) {
    f[0] = __builtin_bit_cast(float, w.x << 16); f[1] = __builtin_bit_cast(float, w.x & 0xffff0000u); f[2] = __builtin_bit_cast(float, w.y << 16); f[3] = __builtin_bit_cast(float, w.y & 0xffff0000u);
    f[4] = __builtin_bit_cast(float, w.z << 16); f[5] = __builtin_bit_cast(float, w.z & 0xffff0000u); f[6] = __builtin_bit_cast(float, w.w << 16); f[7] = __builtin_bit_cast(float, w.w & 0xffff0000u);
}
DEV void xs_lora_phase(const bf16_t* H1, const float* mix, bf16_t* XS0, bf16_t* XS1, bf16_t* XS2, bf16_t* XS3,
                       const bf16_t* w1t, const bf16_t* a1t, bf16_t* LW, bf16_t* LA, int wave, int lane) {
    for (int tile = blockIdx.x; tile < M / 64; tile += gridDim.x) {
        const int m0 = tile * 64;
#pragma unroll 1
        for (int j = 0; j < 2; ++j) {
            const int c = 8 * lane + 512 * j;
            float mx[4][8];
#pragma unroll
            for (int n = 0; n < 4; ++n) { const f32x4 m0v = *(const f32x4*)(mix + n * DM + c), m1v = *(const f32x4*)(mix + n * DM + c + 4);
                mx[n][0] = m0v.x; mx[n][1] = m0v.y; mx[n][2] = m0v.z; mx[n][3] = m0v.w; mx[n][4] = m1v.x; mx[n][5] = m1v.y; mx[n][6] = m1v.z; mx[n][7] = m1v.w; }
#pragma unroll 1
            for (int i = 0; i < 8; ++i) {
                const int m = m0 + 8 * wave + i;
                float h[8], p[8];
                unpack8(*(const u32x4*)(H1 + (size_t)m * DM + c), h);
                if ((m % SEQ) != 0) unpack8(*(const u32x4*)(H1 + (size_t)(m - 1) * DM + c), p);
                else {
#pragma unroll
                    for (int e = 0; e < 8; ++e) p[e] = 0.f;
                }
#pragma unroll
                for (int n = 0; n < 4; ++n) {
                    float o[8];
#pragma unroll
                    for (int e = 0; e < 8; ++e) o[e] = h[e] + (p[e] - h[e]) * mx[n][e];
                    u32x4 w; w.x = pk2(o[0], o[1]); w.y = pk2(o[2], o[3]); w.z = pk2(o[4], o[5]); w.w = pk2(o[6], o[7]);
                    bf16_t* dst = (n == 0) ? XS0 : (n == 1) ? XS1 : (n == 2) ? XS2 : XS3;
                    *(u32x4*)(dst + (size_t)m * DM + c) = w;
                }
            }
        }
        {
            const int mt = wave & 3, mat = wave >> 2, fr = lane & 15, g = lane >> 4;
            const int m = m0 + 16 * mt + fr;
            const bool has_prev = (m % SEQ) != 0;
            const bf16_t* hrow = H1 + (size_t)m * DM; const bf16_t* prow = H1 + (size_t)(m - (has_prev ? 1 : 0)) * DM;
            const float* mxp = mix + (4 + mat) * DM;
            const bf16_t* wt = mat ? a1t : w1t;
            f32x4 acc[4];
#pragma unroll
            for (int nt = 0; nt < 4; ++nt) acc[nt] = (f32x4){0.f, 0.f, 0.f, 0.f};
#pragma unroll 2
            for (int s = 0; s < 32; ++s) {
                const int k0 = 32 * s + 8 * g;
                float h[8], p[8];
                unpack8(*(const u32x4*)(hrow + k0), h); unpack8(*(const u32x4*)(prow + k0), p);
                const f32x4 m0v = *(const f32x4*)(mxp + k0), m1v = *(const f32x4*)(mxp + k0 + 4);
                const float mxv[8] = {m0v.x, m0v.y, m0v.z, m0v.w, m1v.x, m1v.y, m1v.z, m1v.w};
                float o[8];
#pragma unroll
                for (int e = 0; e < 8; ++e) { const float pe = has_prev ? p[e] : 0.f; o[e] = h[e] + (pe - h[e]) * mxv[e]; }
                u32x4 aw; aw.x = pk2(o[0], o[1]); aw.y = pk2(o[2], o[3]); aw.z = pk2(o[4], o[5]); aw.w = pk2(o[6], o[7]);
                const bf16x8_t af = __builtin_bit_cast(bf16x8_t, aw);
#pragma unroll
                for (int nt = 0; nt < 4; ++nt) {
                    const bf16x8_t bfr = *(const bf16x8_t*)(wt + (size_t)(16 * nt + fr) * DM + k0);
                    acc[nt] = __builtin_amdgcn_mfma_f32_16x16x32_bf16(af, bfr, acc[nt], 0, 0, 0);
                }
            }
            bf16_t* dst = mat ? LA : LW;
#pragma unroll
            for (int nt = 0; nt < 4; ++nt)
#pragma unroll
                for (int r = 0; r < 4; ++r) {
                    const float v = acc[nt][r];
                    dst[(size_t)(m0 + 16 * mt + 4 * g + r) * LORA + 16 * nt + fr] = (bf16_t)f2bf(mat ? v : tanhf(v));
                }
        }
    }
}
constexpr int LD = 72;
constexpr int SLOT = 64 * LD * 2;
typedef short bf16x8_t __attribute__((ext_vector_type(8)));
typedef short bf16x4_t __attribute__((ext_vector_type(4)));
#define SLOTP(i) ((LAS bf16_t*)(lds + (i) * SLOT))

DEV void mm64(const LAS bf16_t* A, const LAS bf16_t* Bt, f32x4 (&acc)[2], int wave, int lane) {
    const int mt = wave & 3, nh = wave >> 2, fr = lane & 15, g = lane >> 4;
#pragma unroll
    for (int s = 0; s < 2; ++s) {
        const bf16x8_t a = *(const LAS bf16x8_t*)(A + (16 * mt + fr) * LD + 32 * s + 8 * g);
#pragma unroll
        for (int j = 0; j < 2; ++j) {
            const bf16x8_t b = *(const LAS bf16x8_t*)(Bt + (32 * nh + 16 * j + fr) * LD + 32 * s + 8 * g);
            acc[j] = __builtin_amdgcn_mfma_f32_16x16x32_bf16(a, b, acc[j], 0, 0, 0);
        }
    }
}
DEV void st_rm(LAS bf16_t* D, const f32x4 (&acc)[2], int wave, int lane) {
    const int mt = wave & 3, nh = wave >> 2, fr = lane & 15, g = lane >> 4;
#pragma unroll
    for (int j = 0; j < 2; ++j)
#pragma unroll
        for (int r = 0; r < 4; ++r) D[(16 * mt + 4 * g + r) * LD + 32 * nh + 16 * j + fr] = (bf16_t)f2bf(acc[j][r]);
}
DEV void st_tr(LAS bf16_t* D, const f32x4 (&acc)[2], int wave, int lane) {
    const int mt = wave & 3, nh = wave >> 2, fr = lane & 15, g = lane >> 4;
#pragma unroll
    for (int j = 0; j < 2; ++j) { u32x2 w; w.x = pk2(acc[j][0], acc[j][1]); w.y = pk2(acc[j][2], acc[j][3]);
        *(LAS u32x2*)(D + (32 * nh + 16 * j + fr) * LD + 16 * mt + 4 * g) = w; }
}
#define ZERO2(a) do { a[0] = (f32x4){0.f, 0.f, 0.f, 0.f}; a[1] = (f32x4){0.f, 0.f, 0.f, 0.f}; } while (0)

DEV void rw1_phase(LAS unsigned char* lds, const Args& a, const bf16_t* Rb, const bf16_t* Kb, const bf16_t* Vb, const bf16_t* LWb, const bf16_t* LAb,
                   const bf16_t* w2T, const bf16_t* a2T, bf16_t* RH, bf16_t* YH, bf16_t* PT, bf16_t* GG, float* BON, int wave, int lane) {
    const int tid = threadIdx.x;
    const int mt = wave & 3, nh = wave >> 2, fr = lane & 15, g = lane >> 4;
    LAS float* WP = (LAS float*)(lds + 11 * SLOT);
    LAS float* AP = WP + 4096;
    LAS float* TOT = (LAS float*)(lds + 15 * SLOT);
    LAS float* GC = TOT + 512;
    const float *w0 = a.in[I_W0], *a0 = a.in[I_A0], *k_k = a.in[I_KK], *k_a = a.in[I_KA], *r_k = a.in[I_RK];
    for (int u = blockIdx.x; u < BATCH * NH * (SEQ / 64); u += gridDim.x) {
        const int c = u & 127, bh = u >> 7, h = bh & 15, b = bh >> 4;
        const size_t t0 = (size_t)b * SEQ + (size_t)c * 64;
        {
            const int row = tid >> 3, ch = tid & 7;
            *(LAS u32x4*)(SLOTP(7) + row * LD + 8 * ch) = *(const u32x4*)(LWb + t0 * LORA + tid * 8);
            *(LAS u32x4*)(SLOTP(8) + row * LD + 8 * ch) = *(const u32x4*)(LAb + t0 * LORA + tid * 8);
            *(LAS u32x4*)(SLOTP(9) + row * LD + 8 * ch) = *(const u32x4*)(w2T + (size_t)h * HD * LORA + tid * 8);
            *(LAS u32x4*)(SLOTP(10) + row * LD + 8 * ch) = *(const u32x4*)(a2T + (size_t)h * HD * LORA + tid * 8);
        }
        __syncthreads();
        {
            f32x4 pw[2], pa[2]; ZERO2(pw); ZERO2(pa);
            mm64(SLOTP(7), SLOTP(9), pw, wave, lane); mm64(SLOTP(8), SLOTP(10), pa, wave, lane);
#pragma unroll
            for (int j = 0; j < 2; ++j)
#pragma unroll
                for (int r = 0; r < 4; ++r) { WP[(16 * mt + 4 * g + r) * 64 + 32 * nh + 16 * j + fr] = pw[j][r]; AP[(16 * mt + 4 * g + r) * 64 + 32 * nh + 16 * j + fr] = pa[j][r]; }
        }
        __syncthreads();
        {
            const int d = lane, col = h * HD + d;
            const float w0c = w0[col], a0c = a0[col], kkc = k_k[col], kac = k_a[col], rkc = r_k[col];
            float rr[8], km[8], kn[8], bv[8], vv[8], lm[8], lcl[8];
            float run = 0.f;
#pragma unroll
            for (int i = 0; i < 8; ++i) {
                const int tl = 8 * wave + i; const size_t t = t0 + tl;
                const float r = bf2f(Rb[t * DM + col]), k = bf2f(Kb[t * DM + col]), v = bf2f(Vb[t * DM + col]);
                const float wp = WP[tl * 64 + d] + w0c, ap = AP[tl * 64 + d] + a0c;
                const float xm = -wp; const float sp = xm > 15.f ? xm : __logf(1.f + __expf(xm));
                const float lam = -__expf(-sp - 0.5f);
                const float av = 1.f / (1.f + __expf(-ap));
                const float kkv = k * kkc; const float nrm = sqrtf(wave_sum(kkv * kkv)); const float kkn = kkv / fmaxf(nrm, 1e-12f);
                const float kmod = k * (1.f + (av - 1.f) * kac);
                const float bon = wave_sum(r * kmod * rkc);
                if (lane == 0) BON[t * NH + h] = bon;
                rr[i] = r; km[i] = kmod; kn[i] = kkn; bv[i] = kkn * av; vv[i] = v; lm[i] = lam; run += lam; lcl[i] = run;
            }
            TOT[wave * 64 + d] = run;
            __syncthreads();
            float base = 0.f, total = 0.f;
#pragma unroll
            for (int w2 = 0; w2 < 8; ++w2) { const float tv = TOT[w2 * 64 + d]; total += tv; if (w2 < wave) base += tv; }
            if (wave == 0) GC[d] = __expf(total);
            u32x4 tA, tB, tK, tV;
            float xa[8], xb[8], xk[8];
#pragma unroll
            for (int i = 0; i < 8; ++i) {
                const int tl = 8 * wave + i;
                const float lc = base + lcl[i];
                const float gm = __expf(lc), gp = __expf(lc - lm[i]), ig = __expf(-lc), gr = __expf(total - lc);
                const float Abv = -kn[i] * gp;
                SLOTP(0)[tl * LD + d] = (bf16_t)f2bf(Abv);
                SLOTP(4)[tl * LD + d] = (bf16_t)f2bf(rr[i] * gm);
                SLOTP(1)[tl * LD + d] = (bf16_t)f2bf(bv[i] * ig);
                SLOTP(2)[tl * LD + d] = (bf16_t)f2bf(km[i] * ig);
                xa[i] = Abv; xb[i] = bv[i] * gr; xk[i] = km[i] * gr;
            }
            tA.x = pk2(xa[0], xa[1]); tA.y = pk2(xa[2], xa[3]); tA.z = pk2(xa[4], xa[5]); tA.w = pk2(xa[6], xa[7]);
            tB.x = pk2(xb[0], xb[1]); tB.y = pk2(xb[2], xb[3]); tB.z = pk2(xb[4], xb[5]); tB.w = pk2(xb[6], xb[7]);
            tK.x = pk2(xk[0], xk[1]); tK.y = pk2(xk[2], xk[3]); tK.z = pk2(xk[4], xk[5]); tK.w = pk2(xk[6], xk[7]);
            tV.x = pk2(vv[0], vv[1]); tV.y = pk2(vv[2], vv[3]); tV.z = pk2(vv[4], vv[5]); tV.w = pk2(vv[6], vv[7]);
            *(LAS u32x4*)(SLOTP(3) + d * LD + 8 * wave) = tA;
            *(LAS u32x4*)(SLOTP(5) + d * LD + 8 * wave) = tB;
            *(LAS u32x4*)(SLOTP(6) + d * LD + 8 * wave) = tK;
            *(LAS u32x4*)(SLOTP(7) + d * LD + 8 * wave) = tV;
        }
        __syncthreads();
        f32x4 accT[2];
        {
            f32x4 l1[2], l2[2], m1[2], m2[2]; ZERO2(l1); ZERO2(l2); ZERO2(m1); ZERO2(m2);
            mm64(SLOTP(0), SLOTP(1), l1, wave, lane);
            mm64(SLOTP(0), SLOTP(2), l2, wave, lane);
            mm64(SLOTP(4), SLOTP(1), m1, wave, lane);
            mm64(SLOTP(4), SLOTP(2), m2, wave, lane);
#pragma unroll
            for (int j = 0; j < 2; ++j)
#pragma unroll
                for (int r = 0; r < 4; ++r) { const int t = 16 * mt + 4 * g + r, i = 32 * nh + 16 * j + fr;
                    if (!(i < t)) { l1[j][r] = 0.f; l2[j][r] = 0.f; }
                    if (!(i <= t)) { m1[j][r] = 0.f; m2[j][r] = 0.f; }
                    accT[j][r] = l1[j][r] + (i == t ? 1.f : 0.f); }
            st_rm(SLOTP(8), l1, wave, lane); st_tr(SLOTP(9), l1, wave, lane);
            st_rm(SLOTP(10), l2, wave, lane);
            st_rm(SLOTP(11), m1, wave, lane); st_rm(SLOTP(12), m2, wave, lane);
            st_rm(SLOTP(13), accT, wave, lane);
        }
        __syncthreads();
        {
            f32x4 p2[2], wv[2]; ZERO2(p2); ZERO2(wv);
            mm64(SLOTP(8), SLOTP(9), p2, wave, lane);
            mm64(SLOTP(10), SLOTP(7), wv, wave, lane);
            st_rm(SLOTP(0), p2, wave, lane); st_tr(SLOTP(1), p2, wave, lane);
            st_tr(SLOTP(14), wv, wave, lane);
        }
        __syncthreads();
        int sp_ = 0, st_ = 13;
#pragma unroll 1
        for (int it = 0; it < 5; ++it) {
            const int spT = sp_ + 1, sq_ = (sp_ == 0) ? 8 : 0, stn = (st_ == 13) ? 2 : 13;
            mm64(SLOTP(st_), SLOTP(spT), accT, wave, lane);
            st_rm(SLOTP(stn), accT, wave, lane);
            if (it < 4) { f32x4 p2[2]; ZERO2(p2); mm64(SLOTP(sp_), SLOTP(spT), p2, wave, lane); st_rm(SLOTP(sq_), p2, wave, lane); st_tr(SLOTP(sq_ + 1), p2, wave, lane); }
            sp_ = sq_; st_ = stn;
            __syncthreads();
        }
        {
            f32x4 ah[2], ut[2]; ZERO2(ah); ZERO2(ut);
            mm64(SLOTP(st_), SLOTP(3), ah, wave, lane);
            mm64(SLOTP(st_), SLOTP(14), ut, wave, lane);
            st_tr(SLOTP(10), ah, wave, lane);
            st_tr(SLOTP(8), ut, wave, lane);
        }
        __syncthreads();
        {
            f32x4 rh[2], yh[2], pt[2], gg[2]; ZERO2(rh); ZERO2(yh); ZERO2(pt); ZERO2(gg);
            mm64(SLOTP(11), SLOTP(10), rh, wave, lane);
            mm64(SLOTP(11), SLOTP(8), yh, wave, lane); mm64(SLOTP(12), SLOTP(7), yh, wave, lane);
            mm64(SLOTP(5), SLOTP(10), pt, wave, lane);
            mm64(SLOTP(8), SLOTP(5), gg, wave, lane); mm64(SLOTP(7), SLOTP(6), gg, wave, lane);
#pragma unroll
            for (int j = 0; j < 2; ++j)
#pragma unroll
                for (int r = 0; r < 4; ++r) { const int row = 16 * mt + 4 * g + r, cl = 32 * nh + 16 * j + fr;
                    rh[j][r] += bf2f(SLOTP(4)[row * LD + cl]);
                    if (row == cl) pt[j][r] += GC[row]; }
            st_rm(SLOTP(0), rh, wave, lane); st_rm(SLOTP(1), yh, wave, lane); st_rm(SLOTP(9), pt, wave, lane); st_rm(SLOTP(13), gg, wave, lane);
        }
        __syncthreads();
        {
            const int row = tid >> 3, ch = tid & 7; const size_t go = (size_t)u * 4096 + tid * 8;
            *(u32x4*)(RH + go) = *(const LAS u32x4*)(SLOTP(0) + row * LD + 8 * ch);
            *(u32x4*)(YH + go) = *(const LAS u32x4*)(SLOTP(1) + row * LD + 8 * ch);
            *(u32x4*)(PT + go) = *(const LAS u32x4*)(SLOTP(9) + row * LD + 8 * ch);
            *(u32x4*)(GG + go) = *(const LAS u32x4*)(SLOTP(13) + row * LD + 8 * ch);
        }
        __syncthreads();
    }
}

constexpr int RW2_D = 8;
DEV void rw2_phase(LAS unsigned char* lds, const bf16_t* PT, bf16_t* GG, int wave, int lane) {
    const int tid = threadIdx.x;
    if (blockIdx.x >= BATCH * NH * 4) return;
    const int bh = blockIdx.x >> 2, vs = blockIdx.x & 3;
    const size_t ubase = (size_t)bh * 128;
    LAS bf16_t* Pl[2] = { SLOTP(0), SLOTP(1) };
    LAS bf16_t* Gl[2] = { SLOTP(2), SLOTP(3) };
    const bf16_t* psrc = PT + ubase * 4096 + tid * 8;
    const bf16_t* gsrc = GG + ubase * 4096 + (size_t)vs * 16 * 64 + tid * 8;
    const int prow = tid >> 3, pch = tid & 7;
    u32x4 pr[RW2_D], qr[RW2_D];
#pragma unroll
    for (int i = 0; i < RW2_D; ++i) { pr[i] = *(const u32x4*)(psrc + (size_t)i * 4096); qr[i] = (tid < 128) ? *(const u32x4*)(gsrc + (size_t)i * 4096) : (u32x4){0u, 0u, 0u, 0u}; }
    const int fr = lane & 15, g = lane >> 4;
    f32x4 acc[4];
#pragma unroll
    for (int m = 0; m < 4; ++m) acc[m] = (f32x4){0.f, 0.f, 0.f, 0.f};
#pragma unroll 1
    for (int c0 = 0; c0 < 128; c0 += RW2_D) {
#pragma unroll
        for (int i = 0; i < RW2_D; ++i) {
            const int c = c0 + i, sl = i & 1;
            *(LAS u32x4*)(Pl[sl] + prow * LD + 8 * pch) = pr[i];
            if (tid < 128) *(LAS u32x4*)(Gl[sl] + prow * LD + 8 * pch) = qr[i];
            if (c + RW2_D < 128) { pr[i] = *(const u32x4*)(psrc + (size_t)(c + RW2_D) * 4096); if (tid < 128) qr[i] = *(const u32x4*)(gsrc + (size_t)(c + RW2_D) * 4096); }
            __syncthreads();
            if (wave == 0) {
                bf16_t* sdst = GG + (ubase + c) * 4096 + (size_t)(vs * 16 + fr) * 64;
                u32x2 sb[4];
#pragma unroll
                for (int m = 0; m < 4; ++m) { sb[m].x = pk2(acc[m][0], acc[m][1]); sb[m].y = pk2(acc[m][2], acc[m][3]); *(u32x2*)(sdst + 16 * m + 4 * g) = sb[m]; }
                u32x4 b0, b1; b0.x = sb[0].x; b0.y = sb[0].y; b0.z = sb[1].x; b0.w = sb[1].y; b1.x = sb[2].x; b1.y = sb[2].y; b1.z = sb[3].x; b1.w = sb[3].y;
                const bf16x8_t bf0 = __builtin_bit_cast(bf16x8_t, b0), bf1 = __builtin_bit_cast(bf16x8_t, b1);
#pragma unroll
                for (int m = 0; m < 4; ++m) {
                    const u32x2 gw = *(const LAS u32x2*)(Gl[sl] + fr * LD + 16 * m + 4 * g);
                    f32x4 cin; cin[0] = __builtin_bit_cast(float, gw.x << 16); cin[1] = __builtin_bit_cast(float, gw.x & 0xffff0000u); cin[2] = __builtin_bit_cast(float, gw.y << 16); cin[3] = __builtin_bit_cast(float, gw.y & 0xffff0000u);
                    const LAS bf16_t* prw = Pl[sl] + (16 * m + fr) * LD + 4 * g;
                    const u32x2 a00 = *(const LAS u32x2*)(prw), a01 = *(const LAS u32x2*)(prw + 16), a10 = *(const LAS u32x2*)(prw + 32), a11 = *(const LAS u32x2*)(prw + 48);
                    u32x4 af0, af1; af0.x = a00.x; af0.y = a00.y; af0.z = a01.x; af0.w = a01.y; af1.x = a10.x; af1.y = a10.y; af1.z = a11.x; af1.w = a11.y;
                    cin = __builtin_amdgcn_mfma_f32_16x16x32_bf16(__builtin_bit_cast(bf16x8_t, af0), bf0, cin, 0, 0, 0);
                    cin = __builtin_amdgcn_mfma_f32_16x16x32_bf16(__builtin_bit_cast(bf16x8_t, af1), bf1, cin, 0, 0, 0);
                    acc[m] = cin;
                }
            }
        }
    }
}

DEV void rw3_phase(LAS unsigned char* lds, const Args& a, const bf16_t* RH, const bf16_t* YH, const bf16_t* SS, const float* BON,
                   const bf16_t* Vb, const bf16_t* Gb, bf16_t* OG, int wave, int lane) {
    const int tid = threadIdx.x;
    const int mt = wave & 3, nh = wave >> 2, fr = lane & 15, g = lane >> 4;
    LAS float* YF = (LAS float*)(lds + 4 * SLOT);
    const float *lng = a.in[I_LNG], *lnb = a.in[I_LNB];
    for (int u = blockIdx.x; u < BATCH * NH * (SEQ / 64); u += gridDim.x) {
        const int c = u & 127, bh = u >> 7, h = bh & 15, b = bh >> 4;
        const size_t t0 = (size_t)b * SEQ + (size_t)c * 64;
        {
            const int row = tid >> 3, ch = tid & 7; const size_t go = (size_t)u * 4096 + tid * 8;
            *(LAS u32x4*)(SLOTP(0) + row * LD + 8 * ch) = *(const u32x4*)(RH + go);
            *(LAS u32x4*)(SLOTP(1) + row * LD + 8 * ch) = *(const u32x4*)(SS + go);
            *(LAS u32x4*)(SLOTP(2) + row * LD + 8 * ch) = *(const u32x4*)(YH + go);
        }
        __syncthreads();
        {
            f32x4 y[2]; ZERO2(y);
            mm64(SLOTP(0), SLOTP(1), y, wave, lane);
#pragma unroll
            for (int j = 0; j < 2; ++j)
#pragma unroll
                for (int r = 0; r < 4; ++r) { const int row = 16 * mt + 4 * g + r, cl = 32 * nh + 16 * j + fr;
                    YF[row * 64 + cl] = y[j][r] + bf2f(SLOTP(2)[row * LD + cl]); }
        }
        __syncthreads();
        {
            const int col = h * HD + lane;
            const float lg = lng[col], lb = lnb[col];
#pragma unroll
            for (int i = 0; i < 8; ++i) {
                const int tl = 8 * wave + i; const size_t t = t0 + tl;
                const float y = YF[tl * 64 + lane];
                const float mu = wave_sum(y) * (1.f / HD); const float dy = y - mu;
                const float var = wave_sum(dy * dy) * (1.f / HD);
                const float yn = dy * (1.f / sqrtf(var + LNX_EPS)) * lg + lb;
                const float bon = BON[t * NH + h] * bf2f(Vb[t * DM + col]);
                const float gt = bf2f(Gb[t * DM + col]);
                OG[t * DM + col] = (bf16_t)f2bf((yn + bon) * silu_f(gt));
            }
        }
        __syncthreads();
    }
}
__global__ void __launch_bounds__(NTHREADS, 2) fwd_kernel(Args args) {
    extern __shared__ __attribute__((aligned(16))) unsigned char lds_raw[];
    LAS unsigned char* lds = (LAS unsigned char*)lds_raw;
    const int tid = threadIdx.x, lane = tid & 63, wave = __builtin_amdgcn_readfirstlane(tid >> 6);
    const int G = gridDim.x; const int gw = blockIdx.x * NWAVES + wave, ngw = G * NWAVES;
    unsigned char* ws = args.ws;
    unsigned* ctl = (unsigned*)(ws + WS_CTL);
    volatile LAS unsigned* MISC = (volatile LAS unsigned*)(lds + LDS_BYTES - 64);
    if (tid < 16) MISC[tid] = 0u;
    __syncthreads();
    XcdBarrier bar; bar.bar = ctl + CW_BAR; bar.x = 0; bar.st = nullptr;
    const int lo = args.ph_lo, hi = args.ph_hi;
    if (hi - lo > 1) bar = xcd_barrier_post(ctl + CW_BAR, MISC + 8);
#define IN(k) (lo <= (k) && (k) < hi)
#define SEAM(k) do { if (IN(k) && IN((k) + 1)) xcd_barrier(bar); } while (0)

    const float* x = args.in[I_X]; float* out = args.out;
    bf16_t* H0 = (bf16_t*)(ws + WS_H0); bf16_t* L0 = (bf16_t*)(ws + WS_L0); bf16_t* H1 = (bf16_t*)(ws + WS_H1);
    bf16_t* Qb = (bf16_t*)(ws + WS_Q); bf16_t* Kb = (bf16_t*)(ws + WS_K); bf16_t* Vb = (bf16_t*)(ws + WS_V);
    bf16_t* Gb = (bf16_t*)(ws + WS_G); bf16_t* OG = (bf16_t*)(ws + WS_OG);
    bf16_t* XS0 = (bf16_t*)out; bf16_t* XS1 = (bf16_t*)out + (size_t)M * DM; bf16_t* XS2 = (bf16_t*)(ws + WS_XS2); bf16_t* XS3 = (bf16_t*)(ws + WS_XS3);
    float* KM = (float*)(ws + WS_KM); bf16_t* LW = (bf16_t*)(ws + WS_LW); bf16_t* LA = (bf16_t*)(ws + WS_LA); float* BON = (float*)(ws + WS_BON);
    bf16_t* RH = (bf16_t*)out; bf16_t* YH = (bf16_t*)out + (size_t)M * DM; bf16_t* PT = (bf16_t*)(ws + WS_PT); bf16_t* GG = (bf16_t*)(ws + WS_GG);
    const pg8::bf16_t* win0 = (const pg8::bf16_t*)(ws + WS_WIN0); const pg8::bf16_t* wout0 = (const pg8::bf16_t*)(ws + WS_WOUT0);
    const pg8::bf16_t* win1 = (const pg8::bf16_t*)(ws + WS_WIN1); const pg8::bf16_t* wout1 = (const pg8::bf16_t*)(ws + WS_WOUT1);

    if (IN(0)) { p0_prologue(lds, args, ws, gw, ngw, wave, lane); } SEAM(0);
    if (IN(1)) {
        pg8::Gemm g{H0, win0, M, 4 * DM, DM, nullptr, nullptr, nullptr, 0}; pg8::StaticOrder S; S.init(M, 4 * DM, G, (int)blockIdx.x);
        pg8::EpiBf16<0> E{Qb, DM, nullptr, DM, (size_t)M * DM, 1.f};
        pg8::gemm_phase<pg8::EpiBf16<0>, pg8::StaticOrder, true, true>(lds, g, S, E);
    } SEAM(1);
    if (IN(2)) { kmean_naive(Kb, KM, gw, ngw, lane); } SEAM(2);
    if (IN(3)) { moba_naive(Qb, Kb, Vb, Gb, KM, OG, gw, ngw, lane); } SEAM(3);
    if (IN(4)) {
        pg8::Gemm g{OG, wout0, M, DM, DM, nullptr, nullptr, nullptr, 0}; pg8::StaticOrder S; S.init(M, DM, G, (int)blockIdx.x);
        pg8::EpiRes E{x, nullptr, L0, out};
        pg8::gemm_phase<pg8::EpiRes, pg8::StaticOrder, false, true>(lds, g, S, E);
    } SEAM(4);
    if (IN(5)) { rms_rows<true>(out, args.in[I_RNG], H1, nullptr, gw, ngw, lane); } SEAM(5);
    if (IN(6)) { xs_lora_phase(H1, args.in[I_RMIX], XS0, XS1, XS2, XS3, (const bf16_t*)(ws + WS_W1T), (const bf16_t*)(ws + WS_A1T), LW, LA, wave, lane); } SEAM(6);
    if (IN(7)) {
        pg8::Gemm g{XS0, win1, M, 4 * DM, DM, XS1, XS2, XS3, 1}; pg8::StaticOrder S; S.init(M, 4 * DM, G, (int)blockIdx.x);
        pg8::EpiBf16<0> E{Qb, DM, nullptr, DM, (size_t)M * DM, 1.f};
        pg8::gemm_phase<pg8::EpiBf16<0>, pg8::StaticOrder, true, true>(lds, g, S, E);
    } SEAM(7);
    if (IN(8)) { rw1_phase(lds, args, Qb, Kb, Vb, LW, LA, (const bf16_t*)(ws + WS_W2T), (const bf16_t*)(ws + WS_A2T), RH, YH, PT, GG, BON, wave, lane); } SEAM(8);
    if (IN(9)) { rw2_phase(lds, PT, GG, wave, lane); } SEAM(9);
    if (IN(10)) { rw3_phase(lds, args, RH, YH, GG, BON, Vb, Gb, OG, wave, lane); } SEAM(10);
    if (IN(11)) {
        pg8::Gemm g{OG, wout1, M, DM, DM, nullptr, nullptr, nullptr, 0}; pg8::StaticOrder S; S.init(M, DM, G, (int)blockIdx.x);
        pg8::EpiRes E{x, L0, nullptr, out};
        pg8::gemm_phase<pg8::EpiRes, pg8::StaticOrder, false, true>(lds, g, S, E);
    } SEAM(11);
    if (IN(12)) { rms_rows<false>(out, args.in[I_FNG], nullptr, out, gw, ngw, lane); }
#undef IN
#undef SEAM
}

extern "C" void kernel_launch(void* const* d_in, const int* in_sizes, int n_in, void* d_out, int out_size, void* d_ws, size_t ws_size, hipStream_t stream) {
    static int grid = 0;
    if (grid == 0) {
        if (n_in != 20 || in_sizes[0] != M * DM || out_size != M * DM || ws_size < WS_END) { fprintf(stderr, "kernel_launch: unexpected shapes (n_in %d, in0 %d, out %d, ws %zu)\n", n_in, n_in > 0 ? in_sizes[0] : -1, out_size, ws_size); grid = -1; return; }
        int dev = 0, cus = 0, per_cu = 0;
        if (hipGetDevice(&dev) != hipSuccess || hipDeviceGetAttribute(&cus, hipDeviceAttributeMultiprocessorCount, dev) != hipSuccess) { grid = -1; return; }
        if (hipFuncSetAttribute((const void*)fwd_kernel, hipFuncAttributeMaxDynamicSharedMemorySize, LDS_BYTES) != hipSuccess) { fprintf(stderr, "kernel_launch: hipFuncSetAttribute failed\n"); grid = -1; return; }
        if (hipOccupancyMaxActiveBlocksPerMultiprocessor(&per_cu, (const void*)fwd_kernel, NTHREADS, LDS_BYTES) != hipSuccess || per_cu < 1) { fprintf(stderr, "kernel_launch: occupancy query says %d blocks per CU\n", per_cu); per_cu = 1; }
        (void)hipGetLastError();
        grid = cus;
    }
    if (grid < 0) return;
    (void)hipMemsetAsync((char*)d_ws + WS_CTL, 0, CTL_ZERO_BYTES, stream);
    Args a{};
    for (int i = 0; i < 20; ++i) a.in[i] = (const float*)d_in[i];
    a.out = (float*)d_out; a.ws = (unsigned char*)d_ws;
    if (MK_ONE_LAUNCH) {
        a.ph_lo = 0; a.ph_hi = N_PHASES;
        hipLaunchKernelGGL(fwd_kernel, dim3(grid), dim3(NTHREADS), LDS_BYTES, stream, a);
    } else {
        for (int p = 0; p < N_PHASES; ++p) { a.ph_lo = p; a.ph_hi = p + 1; hipLaunchKernelGGL(fwd_kernel, dim3(grid), dim3(NTHREADS), LDS_BYTES, stream, a); }
    }
}
```

```cpp
#include <hip/hip_runtime.h>
#include <cstdio>
#include <cstdint>
#include <cmath>

#define DEV __device__ __forceinline__
#define LAS __attribute__((address_space(3)))
#define GAS __attribute__((address_space(1)))

typedef unsigned short bf16_t;
typedef float f32x4 __attribute__((ext_vector_type(4)));
typedef float f32x2 __attribute__((ext_vector_type(2)));
typedef unsigned u32x4 __attribute__((ext_vector_type(4)));
typedef unsigned u32x2 __attribute__((ext_vector_type(2)));

constexpr int BATCH = 2, SEQ = 8192, DM = 1024, NH = 16, HD = 64, M = BATCH * SEQ;
constexpr int MBLK = 256, NBLK = SEQ / MBLK, TOPK = 3, LORA = 64;
constexpr float NORM_EPS = 1e-6f, LNX_EPS = 64e-5f;

constexpr int NWAVES = 8, NTHREADS = NWAVES * 64;
constexpr int N_PHASES = 13;
#ifndef MK_ONE_LAUNCH
#define MK_ONE_LAUNCH 1
#endif
constexpr int LDS_BYTES = 147456;

constexpr size_t MiB = 1u << 20;
constexpr size_t WS_CTL = 0, CTL_ZERO_BYTES = 1 * MiB;
constexpr size_t WS_KM = 1 * MiB;
constexpr size_t WS_LW = 2 * MiB, WS_LA = 4 * MiB;
constexpr size_t WS_BON = 6 * MiB;
constexpr size_t WS_WIN0 = 10 * MiB, WS_WOUT0 = 18 * MiB, WS_WIN1 = 20 * MiB, WS_WOUT1 = 28 * MiB;
constexpr size_t WS_W1T = 30 * MiB, WS_A1T = 30 * MiB + 128 * 1024;
constexpr size_t WS_W2T = 30 * MiB + 256 * 1024, WS_A2T = 30 * MiB + 384 * 1024;
constexpr size_t WS_H0 = 32 * MiB, WS_L0 = 32 * MiB;
constexpr size_t WS_Q = 64 * MiB, WS_K = 96 * MiB, WS_V = 128 * MiB, WS_G = 160 * MiB;
constexpr size_t WS_H1 = 64 * MiB;
constexpr size_t WS_OG = 192 * MiB;
constexpr size_t WS_XS2 = 192 * MiB, WS_XS3 = 224 * MiB;
constexpr size_t WS_PT = 192 * MiB, WS_GG = 224 * MiB;
constexpr size_t WS_END = 256 * MiB;
constexpr int CW_BAR = 4096;

DEV float bf2f(unsigned short u) { return __builtin_bit_cast(float, (unsigned)u << 16); }
DEV unsigned f2bf(float f) { unsigned u = __builtin_bit_cast(unsigned, f); return (u + 0x7fffu + ((u >> 16) & 1u)) >> 16; }
DEV unsigned pk2(float lo, float hi) { return f2bf(lo) | (f2bf(hi) << 16); }
DEV float wave_sum(float v) {
#pragma unroll
    for (int o = 1; o < 64; o <<= 1) v += __shfl_xor(v, o);
    return v;
}
DEV float wave_max(float v) {
#pragma unroll
    for (int o = 1; o < 64; o <<= 1) v = fmaxf(v, __shfl_xor(v, o));
    return v;
}
DEV float silu_f(float x) { return x / (1.f + __expf(-x)); }

#define XB_TMO      128
#define XB_XCNT(j)  (256  + 64 * (j))
#define XB_XSUB(j)  (1280 + 64 * (j))
#define XB_XGEN(j)  (2304 + 64 * (j))
#define XB_TOP      3328
#define XB_TOPGEN   3392
#define XCD_BAR_WORDS 3456
#define XB_SPIN_CAP (1u << 20)
DEV unsigned xb_ld(unsigned* p)              { return __hip_atomic_load(p, __ATOMIC_RELAXED, __HIP_MEMORY_SCOPE_AGENT); }
DEV unsigned xb_add(unsigned* p, unsigned v) { return __hip_atomic_fetch_add(p, v, __ATOMIC_RELAXED, __HIP_MEMORY_SCOPE_AGENT); }
DEV unsigned xb_xcc_id() { return (unsigned)__builtin_amdgcn_s_getreg((3 << 11) | 20) & 0xFu; }
#define XB_SPIN(cond, bar) do { unsigned _sp = 0; while (cond) { __builtin_amdgcn_s_sleep(1); \
    if ((++_sp & 255u) == 0u) { if (xb_ld(&(bar)[XB_TMO])) break; if (_sp > XB_SPIN_CAP) { atomicAdd(&(bar)[XB_TMO], 1u); break; } } } } while (0)
struct XcdBarrier { unsigned* bar; unsigned x; volatile LAS unsigned* st; };
DEV XcdBarrier xcd_barrier_post(unsigned* bar, volatile LAS unsigned* st) {
    XcdBarrier b; b.bar = bar; b.x = xb_xcc_id(); b.st = st;
    if (threadIdx.x == 0) (void)xb_add(&bar[XB_XCNT(b.x)], 1u);
    return b;
}
DEV void xcd_barrier_complete(unsigned* bar, unsigned x, unsigned& nloc, unsigned& nx) {
    const unsigned G = gridDim.x * gridDim.y * gridDim.z;
    unsigned sum, cnt, mine, sp = 0u;
    for (;;) {
        sum = 0u; cnt = 0u; mine = 0u;
#pragma unroll
        for (unsigned j = 0; j < 16; ++j) { const unsigned c = xb_ld(&bar[XB_XCNT(j)]); sum += c; cnt += (c > 0u) ? 1u : 0u; mine = (j == x) ? c : mine; }
        if (sum == G) break;
        __builtin_amdgcn_s_sleep(1);
        if ((++sp & 255u) == 0u) { if (xb_ld(&bar[XB_TMO])) break; if (sp > XB_SPIN_CAP) { atomicAdd(&bar[XB_TMO], 1u); break; } }
    }
    nloc = mine > 0u ? mine : 1u; nx = cnt > 0u ? cnt : 1u;
}
DEV void xcd_barrier(const XcdBarrier& b) {
    asm volatile("s_waitcnt vmcnt(0)" ::: "memory");
    __syncthreads();
    if (threadIdx.x == 0) {
        unsigned* bar = b.bar;
        __builtin_amdgcn_s_waitcnt(0);
        unsigned nloc = b.st[0], nx = b.st[1];
        if (nloc == 0u) { xcd_barrier_complete(bar, b.x, nloc, nx); b.st[0] = nloc; b.st[1] = nx; }
        const unsigned old = xb_add(&bar[XB_XSUB(b.x)], 1u);
        const unsigned gen = old / nloc;
        if (old + 1u == (gen + 1u) * nloc) {
            __builtin_amdgcn_fence(__ATOMIC_RELEASE, "agent");
            asm volatile("s_waitcnt vmcnt(0)" ::: "memory");
            const unsigned og = xb_add(&bar[XB_TOP], 1u);
            const unsigned tg = og / nx;
            if (og + 1u == (tg + 1u) * nx) xb_add(&bar[XB_TOPGEN], 1u);
            else XB_SPIN(xb_ld(&bar[XB_TOPGEN]) == tg, bar);
            __builtin_amdgcn_fence(__ATOMIC_ACQUIRE, "agent");
            xb_add(&bar[XB_XGEN(b.x)], 1u);
            asm volatile("s_waitcnt vmcnt(0)" ::: "memory");
        } else {
            XB_SPIN(xb_ld(&bar[XB_XGEN(b.x)]) == gen, bar);
            __builtin_amdgcn_fence(__ATOMIC_ACQUIRE, "agent");
            asm volatile("s_waitcnt vmcnt(0)" ::: "memory");
        }
    }
    __syncthreads();
}

struct Args { const float* in[20]; float* out; unsigned char* ws; int ph_lo, ph_hi; };
enum { I_X = 0, I_MNG, I_MWIN, I_MWOUT, I_RNG, I_RMIX, I_RWIN, I_W0, I_W1, I_W2, I_A0, I_A1, I_A2, I_KK, I_KA, I_RK, I_LNG, I_LNB, I_RWOUT, I_FNG };

namespace pg8 {
#define PG8_LAS __attribute__((address_space(3)))
typedef unsigned short bf16_t;
typedef short bf16x8 __attribute__((ext_vector_type(8)));
typedef float f32x4 __attribute__((ext_vector_type(4)));
typedef unsigned u32x4 __attribute__((ext_vector_type(4)));
constexpr int BM = 256, BK = 64, HALF = 128, HTB = HALF * BK * 2  , STAGE_BYTES = 8 * HTB, NXCD = 8, WGM = 8;

__host__ __device__ __forceinline__ int lds_byte(int r, int c) { const int st = (r >> 4) * 2 + (c >> 5), rr = r & 15, cc = c & 31, ob = rr * 64 + cc * 2; return st * 1024 + (ob ^ (((ob >> 9) & 1) << 5)); }
__host__ __device__ __forceinline__ void stage_rc(int b, int& R, int& C) { const int st = b / 1024, sb = b % 1024, swz = sb ^ (((sb >> 9) & 1) << 5); R = (st >> 1) * 16 + swz / 64; C = (st & 1) * 32 + (swz % 64) / 2; }
__host__ __device__ __forceinline__ int perm32(int rho) { const int n = rho >> 4, i = rho & 15; return 8 * (i >> 2) + 4 * n + (i & 3); }

struct Unit { int pm, pn; };
struct Gemm { const bf16_t* A; const bf16_t* Bt; int M, N, K; const bf16_t* A1; const bf16_t* A2; const bf16_t* A3; int grouped; };
__device__ __forceinline__ const char* a_base(const Gemm& g, const Unit& u, size_t tstep) { const bf16_t* p = g.A; if (g.grouped) { const int s = u.pn >> 2; p = (s == 0) ? g.A : (s == 1) ? g.A1 : (s == 2) ? g.A2 : g.A3; } return (const char*)p + (size_t)u.pm * tstep; }

struct StaticOrder {
    int nM, nN, nwg, G, c;
    __host__ __device__ void init(int M, int N, int G_, int c_) { nM = M / BM; nN = N / BM; nwg = nM * nN; G = G_; c = c_; }
    __host__ __device__ bool next(int i, Unit& u) const {
        const long L = (long)i * G + c; if (L >= nwg) return false;
        int wgid = (int)L; { const int q = nwg / NXCD, r = nwg % NXCD, xcd = wgid % NXCD, off = wgid / NXCD; wgid = (xcd < r ? xcd * (q + 1) : r * (q + 1) + (xcd - r) * q) + off; }
        const int nig = WGM * nN, gid = wgid / nig, fm = gid * WGM, gsz = (nM - fm) < WGM ? (nM - fm) : WGM;
        u.pm = fm + ((wgid % nig) % gsz); u.pn = (wgid % nig) / gsz; return true;
    }
    __device__ __forceinline__ void a_ready(const Unit&) const {}
    __device__ __forceinline__ void done(const Unit&) const {}
};

__device__ __forceinline__ unsigned cvt_pk_bf16(float lo, float hi) { unsigned r; asm volatile("v_cvt_pk_bf16_f32 %0, %1, %2" : "=v"(r) : "v"(lo), "v"(hi)); return r; }
typedef float f32x2 __attribute__((ext_vector_type(2)));
__device__ __forceinline__ f32x2 gelu_pk(f32x2 v) {
    const f32x2 av = __builtin_elementwise_abs(v), d = av * 0.2316418882f + 1.0f;
    f32x2 t; t.x = __builtin_amdgcn_rcpf(d.x); t.y = __builtin_amdgcn_rcpf(d.y);
    f32x2 q = t * 0.5307027145f + (-0.7265760135f); q = q * t + 0.7107068705f; q = q * t + (-0.142248368f); q = q * t + 0.127414796f; q = q * t;
    const f32x2 s = (v * v) * (-0.72134752044f);
    f32x2 e; e.x = __builtin_amdgcn_exp2f(s.x); e.y = __builtin_amdgcn_exp2f(s.y);
    const f32x2 m = v * (q * e), r = v - m;
    f32x2 o; o.x = v.x < 0.f ? m.x : r.x; o.y = v.y < 0.f ? m.y : r.y; return o;
}

template <int ACT  > struct EpiBf16 {
    static constexpr bool PERM = true, AFTER_DRAIN = false; static_assert(ACT == 0 || ACT == 1, "EpiBf16: ACT is 0 (none) or 1 (gelu_pk)");
    bf16_t* O; int ldc; const float* bias; int split_cols; size_t split_stride; float scale0;
    __device__ __forceinline__ void operator()(const f32x4 (&acc)[2][2][4][2], const Unit& u, int wr, int wc, int fr, int fq) const {
        const int row0 = u.pm * BM + wr * 64 + fr; int colt = u.pn * BM; bf16_t* base = O;
        float sc = 1.f; if (split_cols) { const int t = colt / split_cols; base += (size_t)t * split_stride; colt -= t * split_cols; if (t == 0) sc = scale0; }
        const int col0 = colt + wc * 32 + 8 * fq, bcol0 = u.pn * BM + wc * 32 + 8 * fq;
        f32x4 bv[2][2];
#pragma unroll
        for (int bj = 0; bj < 2; ++bj)
#pragma unroll
            for (int n = 0; n < 2; ++n) bv[bj][n] = bias ? *(const f32x4*)(bias + bcol0 + bj * HALF + 4 * n) : (f32x4){0.f, 0.f, 0.f, 0.f};
#pragma unroll
        for (int ai = 0; ai < 2; ++ai)
#pragma unroll
            for (int m = 0; m < 4; ++m) { bf16_t* rowp = base + (size_t)(row0 + ai * HALF + m * 16) * ldc + col0;
#pragma unroll
                for (int bj = 0; bj < 2; ++bj) { f32x4 v0 = acc[ai][bj][m][0] + bv[bj][0], v1 = acc[ai][bj][m][1] + bv[bj][1];
                    if (ACT == 1) { f32x2 a = gelu_pk((f32x2){v0[0], v0[1]}), b = gelu_pk((f32x2){v0[2], v0[3]}), c = gelu_pk((f32x2){v1[0], v1[1]}), d = gelu_pk((f32x2){v1[2], v1[3]});
                        v0 = (f32x4){a.x, a.y, b.x, b.y}; v1 = (f32x4){c.x, c.y, d.x, d.y}; }
                    v0 = v0 * sc; v1 = v1 * sc; u32x4 w; w.x = cvt_pk_bf16(v0[0], v0[1]); w.y = cvt_pk_bf16(v0[2], v0[3]); w.z = cvt_pk_bf16(v1[0], v1[1]); w.w = cvt_pk_bf16(v1[2], v1[3]);
                    *(u32x4*)(rowp + bj * HALF) = w; } }
    }
};

struct EpiRes {
    static constexpr bool PERM = false, AFTER_DRAIN = false;
    const float* base; const bf16_t* l0in; bf16_t* l0out; float* out;
    __device__ __forceinline__ void operator()(const f32x4 (&acc)[2][2][4][2], const Unit& u, int wr, int wc, int fr, int fq) const {
        typedef unsigned u32x2v __attribute__((ext_vector_type(2)));
        const int col0 = u.pn * BM + wc * 32 + 4 * fq;
#pragma unroll
        for (int ai = 0; ai < 2; ++ai)
#pragma unroll
            for (int m = 0; m < 4; ++m) { const size_t roff = (size_t)(u.pm * BM + ai * HALF + wr * 64 + m * 16 + fr) * 1024 + col0;
#pragma unroll
                for (int bj = 0; bj < 2; ++bj)
#pragma unroll
                    for (int n = 0; n < 2; ++n) { const size_t off = roff + bj * HALF + n * 16; const f32x4 v = acc[ai][bj][m][n];
                        f32x4 b = *(const f32x4*)(base + off);
                        if (l0in) { const u32x2v w = *(const u32x2v*)(l0in + off);
                            b[0] += __builtin_bit_cast(float, w.x << 16); b[1] += __builtin_bit_cast(float, w.x & 0xffff0000u); b[2] += __builtin_bit_cast(float, w.y << 16); b[3] += __builtin_bit_cast(float, w.y & 0xffff0000u); }
                        if (l0out) { u32x2v w; w.x = cvt_pk_bf16(v[0], v[1]); w.y = cvt_pk_bf16(v[2], v[3]); *(u32x2v*)(l0out + off) = w; }
                        *(f32x4*)(out + off) = b + v; } }
    }
};

template <class Epi, class Sched, bool ALIGN_EPI = false, bool SP2 = false>
__device__ __forceinline__ void gemm_phase(PG8_LAS unsigned char* lds, const Gemm g, const Sched& S, const Epi& E) {
    const int tid = threadIdx.x, wid = __builtin_amdgcn_readfirstlane(tid >> 6), lane = tid & 63, wr = wid >> 2, wc = wid & 3, fr = lane & 15, fq = lane >> 4;
    const int K = g.K, nt = K / BK;
    unsigned voffA[2], voffB[2];
#pragma unroll
    for (int i = 0; i < 2; ++i) { int R, C; stage_rc(tid * 16 + i * 8192, R, C); const int Rb = Epi::PERM ? ((R & ~31) + perm32(R & 31)) : R;
        voffA[i] = (unsigned)(R * K + C) * 2u; voffB[i] = (unsigned)(Rb * K + C) * 2u; }
    const size_t kstep = (size_t)(BK * 2);
    const size_t hstep = (size_t)HALF * K * 2;
    const size_t tstep = 2 * hstep;
    const unsigned ldsw = (unsigned)wid * 1024u;
    const int aoff = lds_byte(wr * 64 + fr, fq * 8), boff = lds_byte(wc * 32 + fr, fq * 8);
#define PG8_SA(b, h) (((b) * 2 + (h)) * HTB)
#define PG8_SB(b, h) ((4 + (b) * 2 + (h)) * HTB)
#define PG8_STAGE(bufoff, gbase, voff) do { _Pragma("unroll") for (int _i = 0; _i < 2; ++_i) \
        __builtin_amdgcn_global_load_lds((const unsigned*)((const char*)(gbase) + (voff)[_i]), (PG8_LAS unsigned*)(lds + (bufoff) + ldsw + _i * 8192), 16, 0, 0); } while (0)
#define PG8_LDA(dst, b, h) do { _Pragma("unroll") for (int m = 0; m < 4; ++m) _Pragma("unroll") for (int k = 0; k < 2; ++k) dst[m][k] = *(const PG8_LAS bf16x8*)(lds + PG8_SA(b, h) + aoff + m * 2048 + k * 1024); } while (0)
#define PG8_LDB(dst, b, h) do { _Pragma("unroll") for (int n = 0; n < 2; ++n) _Pragma("unroll") for (int k = 0; k < 2; ++k) dst[n][k] = *(const PG8_LAS bf16x8*)(lds + PG8_SB(b, h) + boff + n * 2048 + k * 1024); } while (0)
#define PG8_MMA(ai, bj, At, Bt) do { __builtin_amdgcn_s_setprio(1); _Pragma("unroll") for (int m = 0; m < 4; ++m) _Pragma("unroll") for (int n = 0; n < 2; ++n) _Pragma("unroll") for (int k = 0; k < 2; ++k) \
        acc[ai][bj][m][n] = __builtin_amdgcn_mfma_f32_16x16x32_bf16(Bt[n][k], At[m][k], acc[ai][bj][m][n], 0, 0, 0); __builtin_amdgcn_s_setprio(0); } while (0)
#define PG8_WAIT_V(n) asm volatile("s_waitcnt vmcnt(" #n ")" ::: "memory")
#define PG8_WAIT_L(n) asm volatile("s_waitcnt lgkmcnt(" #n ")" ::: "memory")
#define PG8_BAR __builtin_amdgcn_s_barrier()
#define PG8_SCHED __builtin_amdgcn_sched_barrier(0)
    Unit cur, nxt; int ui = 0;
    if (!S.next(0, cur)) return;
    f32x4 acc[2][2][4][2];
#pragma unroll
    for (int a = 0; a < 2; ++a)
#pragma unroll
        for (int b = 0; b < 2; ++b)
#pragma unroll
            for (int m = 0; m < 4; ++m)
#pragma unroll
                for (int n = 0; n < 2; ++n) acc[a][b][m][n] = (f32x4){0.f, 0.f, 0.f, 0.f};
    bf16x8 At[4][2], B0[2][2], B1[2][2];
    const char* cA = a_base(g, cur, tstep); const char* cB = (const char*)g.Bt + (size_t)cur.pn * tstep;
    S.a_ready(cur);
    if constexpr (SP2) {
        PG8_STAGE(PG8_SB(0, 0), cB, voffB); PG8_STAGE(PG8_SB(0, 1), cB + hstep, voffB); PG8_STAGE(PG8_SA(0, 0), cA, voffA); PG8_STAGE(PG8_SA(0, 1), cA + hstep, voffA);
        if (wr == 1) PG8_BAR;
        PG8_WAIT_V(2); PG8_BAR;
        PG8_STAGE(PG8_SB(1, 0), cB + kstep, voffB); PG8_STAGE(PG8_SA(1, 0), cA + kstep, voffA); PG8_STAGE(PG8_SB(1, 1), cB + hstep + kstep, voffB);
        PG8_WAIT_V(6); PG8_BAR;
    } else {
        PG8_STAGE(PG8_SB(0, 0), cB, voffB); PG8_STAGE(PG8_SA(0, 0), cA, voffA); PG8_STAGE(PG8_SB(0, 1), cB + hstep, voffB); PG8_STAGE(PG8_SA(0, 1), cA + hstep, voffA);
        if (wr == 1) PG8_BAR;
        PG8_WAIT_V(4); PG8_BAR;
        PG8_STAGE(PG8_SB(1, 0), cB + kstep, voffB); PG8_STAGE(PG8_SA(1, 0), cA + kstep, voffA); PG8_STAGE(PG8_SB(1, 1), cB + hstep + kstep, voffB);
        PG8_WAIT_V(6); PG8_BAR;
    }
    for (;;) {
        const bool has_next = S.next(ui + 1, nxt);
        const char* nA = has_next ? a_base(g, nxt, tstep) : cA; const char* nB = has_next ? (const char*)g.Bt + (size_t)nxt.pn * tstep : cB;
        for (int t = 0; t < nt; t += 2) {
            const bool last = (t == nt - 2);
            const char* a1 = cA + (size_t)(t + 1) * kstep;
            const char* a2 = last ? nA : cA + (size_t)(t + 2) * kstep; const char* b2 = last ? nB : cB + (size_t)(t + 2) * kstep;
            const char* a3 = a2 + kstep; const char* b3 = b2 + kstep;
            if (last && has_next) S.a_ready(nxt);
            if constexpr (SP2) {
            PG8_LDB(B0, 0, 0); PG8_LDB(B1, 0, 1); PG8_SCHED; PG8_LDA(At, 0, 0); PG8_STAGE(PG8_SA(1, 1), a1 + hstep, voffA);
            PG8_WAIT_V(8); PG8_WAIT_L(0); PG8_BAR; PG8_MMA(0, 0, At, B0); PG8_MMA(0, 1, At, B1); PG8_BAR; PG8_SCHED;
            PG8_LDA(At, 0, 1); PG8_STAGE(PG8_SB(0, 0), b2, voffB); PG8_STAGE(PG8_SB(0, 1), b2 + hstep, voffB); PG8_STAGE(PG8_SA(0, 0), a2, voffA);
            PG8_WAIT_V(8); PG8_WAIT_L(0); PG8_BAR; PG8_MMA(1, 0, At, B0); PG8_MMA(1, 1, At, B1); PG8_BAR; PG8_SCHED;
            PG8_LDB(B0, 1, 0); PG8_LDB(B1, 1, 1); PG8_SCHED; PG8_LDA(At, 1, 0); PG8_STAGE(PG8_SA(0, 1), a2 + hstep, voffA);
            PG8_WAIT_V(8); PG8_WAIT_L(0); PG8_BAR; PG8_MMA(0, 0, At, B0); PG8_MMA(0, 1, At, B1); PG8_BAR; PG8_SCHED;
            PG8_LDA(At, 1, 1); PG8_STAGE(PG8_SB(1, 0), b3, voffB); PG8_STAGE(PG8_SB(1, 1), b3 + hstep, voffB); PG8_STAGE(PG8_SA(1, 0), a3, voffA);
            PG8_WAIT_V(8); PG8_WAIT_L(0); PG8_BAR; PG8_MMA(1, 0, At, B0); PG8_MMA(1, 1, At, B1); PG8_BAR; PG8_SCHED;
            } else {
            PG8_LDB(B0, 0, 0); PG8_SCHED; PG8_LDA(At, 0, 0); PG8_STAGE(PG8_SA(1, 1), a1 + hstep, voffA);
            PG8_WAIT_L(8); PG8_BAR; PG8_WAIT_L(0); PG8_MMA(0, 0, At, B0); PG8_BAR; PG8_SCHED;
            PG8_LDB(B1, 0, 1); PG8_STAGE(PG8_SB(0, 0), b2, voffB);
            PG8_BAR; PG8_WAIT_L(0); PG8_MMA(0, 1, At, B1); PG8_BAR;
            PG8_LDA(At, 0, 1); PG8_STAGE(PG8_SA(0, 0), a2, voffA);
            PG8_BAR; PG8_WAIT_L(0); PG8_MMA(1, 0, At, B0); PG8_BAR; PG8_SCHED;
            PG8_STAGE(PG8_SB(0, 1), b2 + hstep, voffB);
            PG8_WAIT_V(6); PG8_BAR; PG8_MMA(1, 1, At, B1); PG8_BAR;
            PG8_LDB(B0, 1, 0); PG8_SCHED; PG8_LDA(At, 1, 0); PG8_STAGE(PG8_SA(0, 1), a2 + hstep, voffA);
            PG8_WAIT_L(8); PG8_BAR; PG8_WAIT_L(0); PG8_MMA(0, 0, At, B0); PG8_BAR; PG8_SCHED;
            PG8_LDB(B1, 1, 1); PG8_STAGE(PG8_SB(1, 0), b3, voffB);
            PG8_BAR; PG8_WAIT_L(0); PG8_MMA(0, 1, At, B1); PG8_BAR;
            PG8_LDA(At, 1, 1); PG8_STAGE(PG8_SA(1, 0), a3, voffA);
            PG8_BAR; PG8_WAIT_L(0); PG8_MMA(1, 0, At, B0); PG8_BAR; PG8_SCHED;
            PG8_STAGE(PG8_SB(1, 1), b3 + hstep, voffB);
            PG8_WAIT_V(6); PG8_BAR; PG8_MMA(1, 1, At, B1); PG8_BAR;
            }
        }
        if constexpr (ALIGN_EPI) { if (wr == 0) PG8_BAR; }
        if constexpr (!Epi::AFTER_DRAIN) { E(acc, cur, wr, wc, fr, fq); S.done(cur); }
        if (!has_next) break;
#pragma unroll
        for (int a = 0; a < 2; ++a)
#pragma unroll
            for (int b = 0; b < 2; ++b)
#pragma unroll
                for (int m = 0; m < 4; ++m)
#pragma unroll
                    for (int n = 0; n < 2; ++n) acc[a][b][m][n] = (f32x4){0.f, 0.f, 0.f, 0.f};
        cur = nxt; cA = nA; cB = nB; ++ui;
        if constexpr (ALIGN_EPI) { if (wr == 1) PG8_BAR; }
    }
    PG8_WAIT_V(0);
    if constexpr (!ALIGN_EPI) { if (wr == 0) PG8_BAR; }
    PG8_BAR;
    if constexpr (Epi::AFTER_DRAIN) { E.fused(acc, cur, wr, wc, fr, fq, lds, wid, lane); S.done(cur); }
#undef PG8_SA
#undef PG8_SB
#undef PG8_STAGE
#undef PG8_LDA
#undef PG8_LDB
#undef PG8_MMA
#undef PG8_WAIT_V
#undef PG8_WAIT_L
#undef PG8_BAR
#undef PG8_SCHED
}
}
template <bool OUT_BF16>
DEV void rms_rows(const float* xin, const float* g, bf16_t* ob, float* of, int gw, int ngw, int lane) {
    for (int m = gw; m < M; m += ngw) {
        const f32x4* xr = (const f32x4*)(xin + (size_t)m * DM) + lane;
        f32x4 v[4]; float s = 0.f;
#pragma unroll
        for (int j = 0; j < 4; ++j) { v[j] = xr[64 * j]; s += (v[j].x * v[j].x + v[j].y * v[j].y) + (v[j].z * v[j].z + v[j].w * v[j].w); }
        const float rstd = 1.f / sqrtf(wave_sum(s) * (1.f / DM) + NORM_EPS);
#pragma unroll
        for (int j = 0; j < 4; ++j) {
            const f32x4 gv = *((const f32x4*)g + lane + 64 * j);
            const f32x4 o = v[j] * rstd * gv;
            if (OUT_BF16) { u32x2 w; w.x = pk2(o.x, o.y); w.y = pk2(o.z, o.w); *((u32x2*)(ob + (size_t)m * DM) + lane + 64 * j) = w; }
            else *((f32x4*)(of + (size_t)m * DM) + lane + 64 * j) = o;
        }
    }
}

DEV void kmean_phase(const bf16_t* Kb, bf16_t* KMH, bf16_t* KML, int gw, int ngw, int lane) {
    for (int it = gw; it < BATCH * NH * NBLK; it += ngw) {
        const int j = it % NBLK, h = (it / NBLK) % NH, b = it / (NBLK * NH);
        const bf16_t* kp = Kb + ((size_t)b * SEQ + (size_t)j * MBLK) * DM + h * HD + lane;
        float s0 = 0.f, s1 = 0.f, s2 = 0.f, s3 = 0.f;
        for (int i = 0; i < MBLK; i += 4) { s0 += bf2f(kp[(size_t)i * DM]); s1 += bf2f(kp[(size_t)(i + 1) * DM]); s2 += bf2f(kp[(size_t)(i + 2) * DM]); s3 += bf2f(kp[(size_t)(i + 3) * DM]); }
        const float mean = ((s0 + s1) + (s2 + s3)) * (1.f / MBLK);
        const unsigned hb = f2bf(mean); const float lo = mean - bf2f((unsigned short)hb);
        KMH[(size_t)it * HD + lane] = (bf16_t)hb; KML[(size_t)it * HD + lane] = (bf16_t)f2bf(lo);
    }
}


#define LDS_WAIT() asm volatile("s_waitcnt lgkmcnt(0)" ::: "memory")
__device__ __forceinline__ void p0_transpose_item(const float* W, int K, int N, bf16_t* WT, int row_off, LAS float* scr, int item, int lane) {
    const int nblk = N / 32, kb = item / nblk, nb = item % nblk, k0 = 64 * kb, n0 = 32 * nb;
#pragma unroll 8
    for (int i = 0; i < 32; ++i) { const int kk = 2 * i + (lane >> 5); scr[kk * 33 + (lane & 31)] = W[(size_t)(k0 + kk) * N + n0 + (lane & 31)]; }
    LDS_WAIT(); asm volatile("" ::: "memory");
    const int c = lane & 7;
#pragma unroll
    for (int j = 0; j < 4; ++j) { const int n = (lane >> 3) + 8 * j; const LAS float* s = scr + (8 * c) * 33 + n;
        u32x4 o; o.x = pk2(s[0 * 33], s[1 * 33]); o.y = pk2(s[2 * 33], s[3 * 33]); o.z = pk2(s[4 * 33], s[5 * 33]); o.w = pk2(s[6 * 33], s[7 * 33]);
        *(GAS u32x4*)(WT + (size_t)(row_off + n0 + n) * K + k0 + 8 * c) = o; }
    LDS_WAIT(); asm volatile("" ::: "memory");
}

DEV void p0_prologue(LAS unsigned char* lds, const Args& a, unsigned char* ws, int gw, int ngw, int wave, int lane) {
    LAS float* scr = (LAS float*)(lds + wave * 16384);
    constexpr int I_IN = (DM / 64) * (4 * DM / 32), I_SQ = (DM / 64) * (DM / 32), I_LO = (DM / 64) * (LORA / 32);
    constexpr int I_UP = (LORA / 64) * (DM / 32);
    constexpr int NITEMS = I_IN + I_SQ + 4 * I_SQ + I_SQ + 2 * I_LO + 2 * I_UP;
    bf16_t* win0 = (bf16_t*)(ws + WS_WIN0); bf16_t* wout0 = (bf16_t*)(ws + WS_WOUT0); bf16_t* win1 = (bf16_t*)(ws + WS_WIN1); bf16_t* wout1 = (bf16_t*)(ws + WS_WOUT1);
    bf16_t* w1t = (bf16_t*)(ws + WS_W1T); bf16_t* a1t = (bf16_t*)(ws + WS_A1T);
    for (int it = gw; it < NITEMS; it += ngw) {
        int r = it;
        if (r < I_IN) { p0_transpose_item(a.in[I_MWIN], DM, 4 * DM, win0, 0, scr, r, lane); continue; } r -= I_IN;
        if (r < I_SQ) { p0_transpose_item(a.in[I_MWOUT], DM, DM, wout0, 0, scr, r, lane); continue; } r -= I_SQ;
        if (r < 4 * I_SQ) { const int s = r / I_SQ; p0_transpose_item(a.in[I_RWIN] + (size_t)s * DM * DM, DM, DM, win1, s * DM, scr, r % I_SQ, lane); continue; } r -= 4 * I_SQ;
        if (r < I_SQ) { p0_transpose_item(a.in[I_RWOUT], DM, DM, wout1, 0, scr, r, lane); continue; } r -= I_SQ;
        if (r < I_LO) { p0_transpose_item(a.in[I_W1], DM, LORA, w1t, 0, scr, r, lane); continue; } r -= I_LO;
        if (r < I_LO) { p0_transpose_item(a.in[I_A1], DM, LORA, a1t, 0, scr, r, lane); continue; } r -= I_LO;
        if (r < I_UP) { p0_transpose_item(a.in[I_W2], LORA, DM, (bf16_t*)(ws + WS_W2T), 0, scr, r, lane); continue; } r -= I_UP;
        p0_transpose_item(a.in[I_A2], LORA, DM, (bf16_t*)(ws + WS_A2T), 0, scr, r, lane);
    }
    rms_rows<true>(a.in[I_X], a.in[I_MNG], (bf16_t*)(ws + WS_H0), nullptr, gw, ngw, lane);
}

typedef short bf16x8_t __attribute__((ext_vector_type(8)));
DEV void unpack8(const u32x4 w, float (&f)[8]) {
    f[0] = __builtin_bit_cast(float, w.x << 16); f[1] = __builtin_bit_cast(float, w.x & 0xffff0000u); f[2] = __builtin_bit_cast(float, w.y << 16); f[3] = __builtin_bit_cast(float, w.y & 0xffff0000u);
    f[4] = __builtin_bit_cast(float, w.z << 16); f[5] = __builtin_bit_cast(float, w.z & 0xffff0000u); f[6] = __builtin_bit_cast(float, w.w << 16); f[7] = __builtin_bit_cast(float, w.w & 0xffff0000u);
}
DEV void xs_lora_phase(const bf16_t* H1, const float* mix, bf16_t* XS0, bf16_t* XS1, bf16_t* XS2, bf16_t* XS3,
                       const bf16_t* w1t, const bf16_t* a1t, bf16_t* LW, bf16_t* LA, int wave, int lane) {
    for (int tile = blockIdx.x; tile < M / 64; tile += gridDim.x) {
        const int m0 = tile * 64;
#pragma unroll 1
        for (int j = 0; j < 2; ++j) {
            const int c = 8 * lane + 512 * j;
            float mx[4][8];
#pragma unroll
            for (int n = 0; n < 4; ++n) { const f32x4 m0v = *(const f32x4*)(mix + n * DM + c), m1v = *(const f32x4*)(mix + n * DM + c + 4);
                mx[n][0] = m0v.x; mx[n][1] = m0v.y; mx[n][2] = m0v.z; mx[n][3] = m0v.w; mx[n][4] = m1v.x; mx[n][5] = m1v.y; mx[n][6] = m1v.z; mx[n][7] = m1v.w; }
#pragma unroll 1
            for (int i = 0; i < 8; ++i) {
                const int m = m0 + 8 * wave + i;
                float h[8], p[8];
                unpack8(*(const u32x4*)(H1 + (size_t)m * DM + c), h);
                if ((m % SEQ) != 0) unpack8(*(const u32x4*)(H1 + (size_t)(m - 1) * DM + c), p);
                else {
#pragma unroll
                    for (int e = 0; e < 8; ++e) p[e] = 0.f;
                }
#pragma unroll
                for (int n = 0; n < 4; ++n) {
                    float o[8];
#pragma unroll
                    for (int e = 0; e < 8; ++e) o[e] = h[e] + (p[e] - h[e]) * mx[n][e];
                    u32x4 w; w.x = pk2(o[0], o[1]); w.y = pk2(o[2], o[3]); w.z = pk2(o[4], o[5]); w.w = pk2(o[6], o[7]);
                    bf16_t* dst = (n == 0) ? XS0 : (n == 1) ? XS1 : (n == 2) ? XS2 : XS3;
                    *(u32x4*)(dst + (size_t)m * DM + c) = w;
                }
            }
        }
        {
            const int mt = wave & 3, mat = wave >> 2, fr = lane & 15, g = lane >> 4;
            const int m = m0 + 16 * mt + fr;
            const bool has_prev = (m % SEQ) != 0;
            const bf16_t* hrow = H1 + (size_t)m * DM; const bf16_t* prow = H1 + (size_t)(m - (has_prev ? 1 : 0)) * DM;
            const float* mxp = mix + (4 + mat) * DM;
            const bf16_t* wt = mat ? a1t : w1t;
            f32x4 acc[4];
#pragma unroll
            for (int nt = 0; nt < 4; ++nt) acc[nt] = (f32x4){0.f, 0.f, 0.f, 0.f};
#pragma unroll 2
            for (int s = 0; s < 32; ++s) {
                const int k0 = 32 * s + 8 * g;
                float h[8], p[8];
                unpack8(*(const u32x4*)(hrow + k0), h); unpack8(*(const u32x4*)(prow + k0), p);
                const f32x4 m0v = *(const f32x4*)(mxp + k0), m1v = *(const f32x4*)(mxp + k0 + 4);
                const float mxv[8] = {m0v.x, m0v.y, m0v.z, m0v.w, m1v.x, m1v.y, m1v.z, m1v.w};
                float o[8];
#pragma unroll
                for (int e = 0; e < 8; ++e) { const float pe = has_prev ? p[e] : 0.f; o[e] = h[e] + (pe - h[e]) * mxv[e]; }
                u32x4 aw; aw.x = pk2(o[0], o[1]); aw.y = pk2(o[2], o[3]); aw.z = pk2(o[4], o[5]); aw.w = pk2(o[6], o[7]);
                const bf16x8_t af = __builtin_bit_cast(bf16x8_t, aw);
#pragma unroll
                for (int nt = 0; nt < 4; ++nt) {
                    const bf16x8_t bfr = *(const bf16x8_t*)(wt + (size_t)(16 * nt + fr) * DM + k0);
                    acc[nt] = __builtin_amdgcn_mfma_f32_16x16x32_bf16(af, bfr, acc[nt], 0, 0, 0);
                }
            }
            bf16_t* dst = mat ? LA : LW;
#pragma unroll
            for (int nt = 0; nt < 4; ++nt)
#pragma unroll
                for (int r = 0; r < 4; ++r) {
                    const float v = acc[nt][r];
                    dst[(size_t)(m0 + 16 * mt + 4 * g + r) * LORA + 16 * nt + fr] = (bf16_t)f2bf(mat ? v : tanhf(v));
                }
        }
    }
}
constexpr int LD = 72;
constexpr int SLOT = 64 * LD * 2;
typedef short bf16x8_t __attribute__((ext_vector_type(8)));
typedef short bf16x4_t __attribute__((ext_vector_type(4)));
#define SLOTP(i) ((LAS bf16_t*)(lds + (i) * SLOT))

DEV void mm64(const LAS bf16_t* A, const LAS bf16_t* Bt, f32x4 (&acc)[2], int wave, int lane) {
    const int mt = wave & 3, nh = wave >> 2, fr = lane & 15, g = lane >> 4;
#pragma unroll
    for (int s = 0; s < 2; ++s) {
        const bf16x8_t a = *(const LAS bf16x8_t*)(A + (16 * mt + fr) * LD + 32 * s + 8 * g);
#pragma unroll
        for (int j = 0; j < 2; ++j) {
            const bf16x8_t b = *(const LAS bf16x8_t*)(Bt + (32 * nh + 16 * j + fr) * LD + 32 * s + 8 * g);
            acc[j] = __builtin_amdgcn_mfma_f32_16x16x32_bf16(a, b, acc[j], 0, 0, 0);
        }
    }
}
DEV void st_rm(LAS bf16_t* D, const f32x4 (&acc)[2], int wave, int lane) {
    const int mt = wave & 3, nh = wave >> 2, fr = lane & 15, g = lane >> 4;
#pragma unroll
    for (int j = 0; j < 2; ++j)
#pragma unroll
        for (int r = 0; r < 4; ++r) D[(16 * mt + 4 * g + r) * LD + 32 * nh + 16 * j + fr] = (bf16_t)f2bf(acc[j][r]);
}
DEV void st_tr(LAS bf16_t* D, const f32x4 (&acc)[2], int wave, int lane) {
    const int mt = wave & 3, nh = wave >> 2, fr = lane & 15, g = lane >> 4;
#pragma unroll
    for (int j = 0; j < 2; ++j) { u32x2 w; w.x = pk2(acc[j][0], acc[j][1]); w.y = pk2(acc[j][2], acc[j][3]);
        *(LAS u32x2*)(D + (32 * nh + 16 * j + fr) * LD + 16 * mt + 4 * g) = w; }
}
#define ZERO2(a) do { a[0] = (f32x4){0.f, 0.f, 0.f, 0.f}; a[1] = (f32x4){0.f, 0.f, 0.f, 0.f}; } while (0)

DEV void rw1_phase(LAS unsigned char* lds, const Args& a, const bf16_t* Rb, const bf16_t* Kb, const bf16_t* Vb, const bf16_t* LWb, const bf16_t* LAb,
                   const bf16_t* w2T, const bf16_t* a2T, bf16_t* RH, bf16_t* YH, bf16_t* PT, bf16_t* GG, float* BON, int wave, int lane) {
    const int tid = threadIdx.x;
    const int mt = wave & 3, nh = wave >> 2, fr = lane & 15, g = lane >> 4;
    LAS float* WP = (LAS float*)(lds + 11 * SLOT);
    LAS float* AP = WP + 4096;
    LAS float* TOT = (LAS float*)(lds + 15 * SLOT);
    LAS float* GC = TOT + 512;
    const float *w0 = a.in[I_W0], *a0 = a.in[I_A0], *k_k = a.in[I_KK], *k_a = a.in[I_KA], *r_k = a.in[I_RK];
    for (int u = blockIdx.x; u < BATCH * NH * (SEQ / 64); u += gridDim.x) {
        const int c = u & 127, bh = u >> 7, h = bh & 15, b = bh >> 4;
        const size_t t0 = (size_t)b * SEQ + (size_t)c * 64;
        {
            const int row = tid >> 3, ch = tid & 7;
            *(LAS u32x4*)(SLOTP(7) + row * LD + 8 * ch) = *(const u32x4*)(LWb + t0 * LORA + tid * 8);
            *(LAS u32x4*)(SLOTP(8) + row * LD + 8 * ch) = *(const u32x4*)(LAb + t0 * LORA + tid * 8);
            *(LAS u32x4*)(SLOTP(9) + row * LD + 8 * ch) = *(const u32x4*)(w2T + (size_t)h * HD * LORA + tid * 8);
            *(LAS u32x4*)(SLOTP(10) + row * LD + 8 * ch) = *(const u32x4*)(a2T + (size_t)h * HD * LORA + tid * 8);
        }
        __syncthreads();
        {
            f32x4 pw[2], pa[2]; ZERO2(pw); ZERO2(pa);
            mm64(SLOTP(7), SLOTP(9), pw, wave, lane); mm64(SLOTP(8), SLOTP(10), pa, wave, lane);
#pragma unroll
            for (int j = 0; j < 2; ++j)
#pragma unroll
                for (int r = 0; r < 4; ++r) { WP[(16 * mt + 4 * g + r) * 64 + 32 * nh + 16 * j + fr] = pw[j][r]; AP[(16 * mt + 4 * g + r) * 64 + 32 * nh + 16 * j + fr] = pa[j][r]; }
        }
        __syncthreads();
        {
            const int d = lane, col = h * HD + d;
            const float w0c = w0[col], a0c = a0[col], kkc = k_k[col], kac = k_a[col], rkc = r_k[col];
            float rr[8], km[8], kn[8], bv[8], vv[8], lm[8], lcl[8];
            float run = 0.f;
#pragma unroll
            for (int i = 0; i < 8; ++i) {
                const int tl = 8 * wave + i; const size_t t = t0 + tl;
                const float r = bf2f(Rb[t * DM + col]), k = bf2f(Kb[t * DM + col]), v = bf2f(Vb[t * DM + col]);
                const float wp = WP[tl * 64 + d] + w0c, ap = AP[tl * 64 + d] + a0c;
                const float xm = -wp; const float sp = xm > 15.f ? xm : __logf(1.f + __expf(xm));
                const float lam = -__expf(-sp - 0.5f);
                const float av = 1.f / (1.f + __expf(-ap));
                const float kkv = k * kkc; const float nrm = sqrtf(wave_sum(kkv * kkv)); const float kkn = kkv / fmaxf(nrm, 1e-12f);
                const float kmod = k * (1.f + (av - 1.f) * kac);
                const float bon = wave_sum(r * kmod * rkc);
                if (lane == 0) BON[t * NH + h] = bon;
                rr[i] = r; km[i] = kmod; kn[i] = kkn; bv[i] = kkn * av; vv[i] = v; lm[i] = lam; run += lam; lcl[i] = run;
            }
            TOT[wave * 64 + d] = run;
            __syncthreads();
            float base = 0.f, total = 0.f;
#pragma unroll
            for (int w2 = 0; w2 < 8; ++w2) { const float tv = TOT[w2 * 64 + d]; total += tv; if (w2 < wave) base += tv; }
            if (wave == 0) GC[d] = __expf(total);
            u32x4 tA, tB, tK, tV;
            float xa[8], xb[8], xk[8];
#pragma unroll
            for (int i = 0; i < 8; ++i) {
                const int tl = 8 * wave + i;
                const float lc = base + lcl[i];
                const float gm = __expf(lc), gp = __expf(lc - lm[i]), ig = __expf(-lc), gr = __expf(total - lc);
                const float Abv = -kn[i] * gp;
                SLOTP(0)[tl * LD + d] = (bf16_t)f2bf(Abv);
                SLOTP(4)[tl * LD + d] = (bf16_t)f2bf(rr[i] * gm);
                SLOTP(1)[tl * LD + d] = (bf16_t)f2bf(bv[i] * ig);
                SLOTP(2)[tl * LD + d] = (bf16_t)f2bf(km[i] * ig);
                xa[i] = Abv; xb[i] = bv[i] * gr; xk[i] = km[i] * gr;
            }
            tA.x = pk2(xa[0], xa[1]); tA.y = pk2(xa[2], xa[3]); tA.z = pk2(xa[4], xa[5]); tA.w = pk2(xa[6], xa[7]);
            tB.x = pk2(xb[0], xb[1]); tB.y = pk2(xb[2], xb[3]); tB.z = pk2(xb[4], xb[5]); tB.w = pk2(xb[6], xb[7]);
            tK.x = pk2(xk[0], xk[1]); tK.y = pk2(xk[2], xk[3]); tK.z = pk2(xk[4], xk[5]); tK.w = pk2(xk[6], xk[7]);
            tV.x = pk2(vv[0], vv[1]); tV.y = pk2(vv[2], vv[3]); tV.z = pk2(vv[4], vv[5]); tV.w = pk2(vv[6], vv[7]);
            *(LAS u32x4*)(SLOTP(3) + d * LD + 8 * wave) = tA;
            *(LAS u32x4*)(SLOTP(5) + d * LD + 8 * wave) = tB;
            *(LAS u32x4*)(SLOTP(6) + d * LD + 8 * wave) = tK;
            *(LAS u32x4*)(SLOTP(7) + d * LD + 8 * wave) = tV;
        }
        __syncthreads();
        f32x4 accT[2];
        {
            f32x4 l1[2], l2[2], m1[2], m2[2]; ZERO2(l1); ZERO2(l2); ZERO2(m1); ZERO2(m2);
            mm64(SLOTP(0), SLOTP(1), l1, wave, lane);
            mm64(SLOTP(0), SLOTP(2), l2, wave, lane);
            mm64(SLOTP(4), SLOTP(1), m1, wave, lane);
            mm64(SLOTP(4), SLOTP(2), m2, wave, lane);
#pragma unroll
            for (int j = 0; j < 2; ++j)
#pragma unroll
                for (int r = 0; r < 4; ++r) { const int t = 16 * mt + 4 * g + r, i = 32 * nh + 16 * j + fr;
                    if (!(i < t)) { l1[j][r] = 0.f; l2[j][r] = 0.f; }
                    if (!(i <= t)) { m1[j][r] = 0.f; m2[j][r] = 0.f; }
                    accT[j][r] = l1[j][r] + (i == t ? 1.f : 0.f); }
            st_rm(SLOTP(8), l1, wave, lane); st_tr(SLOTP(9), l1, wave, lane);
            st_rm(SLOTP(10), l2, wave, lane);
            st_rm(SLOTP(11), m1, wave, lane); st_rm(SLOTP(12), m2, wave, lane);
            st_rm(SLOTP(13), accT, wave, lane);
        }
        __syncthreads();
        {
            f32x4 p2[2], wv[2]; ZERO2(p2); ZERO2(wv);
            mm64(SLOTP(8), SLOTP(9), p2, wave, lane);
            mm64(SLOTP(10), SLOTP(7), wv, wave, lane);
            st_rm(SLOTP(0), p2, wave, lane); st_tr(SLOTP(1), p2, wave, lane);
            st_tr(SLOTP(14), wv, wave, lane);
        }
        __syncthreads();
        int sp_ = 0, st_ = 13;
#pragma unroll 1
        for (int it = 0; it < 5; ++it) {
            const int spT = sp_ + 1, sq_ = (sp_ == 0) ? 8 : 0, stn = (st_ == 13) ? 2 : 13;
            mm64(SLOTP(st_), SLOTP(spT), accT, wave, lane);
            st_rm(SLOTP(stn), accT, wave, lane);
            if (it < 4) { f32x4 p2[2]; ZERO2(p2); mm64(SLOTP(sp_), SLOTP(spT), p2, wave, lane); st_rm(SLOTP(sq_), p2, wave, lane); st_tr(SLOTP(sq_ + 1), p2, wave, lane); }
            sp_ = sq_; st_ = stn;
            __syncthreads();
        }
        {
            f32x4 ah[2], ut[2]; ZERO2(ah); ZERO2(ut);
            mm64(SLOTP(st_), SLOTP(3), ah, wave, lane);
            mm64(SLOTP(st_), SLOTP(14), ut, wave, lane);
            st_tr(SLOTP(10), ah, wave, lane);
            st_tr(SLOTP(8), ut, wave, lane);
        }
        __syncthreads();
        {
            f32x4 rh[2], yh[2], pt[2], gg[2]; ZERO2(rh); ZERO2(yh); ZERO2(pt); ZERO2(gg);
            mm64(SLOTP(11), SLOTP(10), rh, wave, lane);
            mm64(SLOTP(11), SLOTP(8), yh, wave, lane); mm64(SLOTP(12), SLOTP(7), yh, wave, lane);
            mm64(SLOTP(5), SLOTP(10), pt, wave, lane);
            mm64(SLOTP(8), SLOTP(5), gg, wave, lane); mm64(SLOTP(7), SLOTP(6), gg, wave, lane);
#pragma unroll
            for (int j = 0; j < 2; ++j)
#pragma unroll
                for (int r = 0; r < 4; ++r) { const int row = 16 * mt + 4 * g + r, cl = 32 * nh + 16 * j + fr;
                    rh[j][r] += bf2f(SLOTP(4)[row * LD + cl]);
                    if (row == cl) pt[j][r] += GC[row]; }
            st_rm(SLOTP(0), rh, wave, lane); st_rm(SLOTP(1), yh, wave, lane); st_rm(SLOTP(9), pt, wave, lane); st_rm(SLOTP(13), gg, wave, lane);
        }
        __syncthreads();
        {
            const int row = tid >> 3, ch = tid & 7; const size_t go = (size_t)u * 4096 + tid * 8;
            *(u32x4*)(RH + go) = *(const LAS u32x4*)(SLOTP(0) + row * LD + 8 * ch);
            *(u32x4*)(YH + go) = *(const LAS u32x4*)(SLOTP(1) + row * LD + 8 * ch);
            *(u32x4*)(PT + go) = *(const LAS u32x4*)(SLOTP(9) + row * LD + 8 * ch);
            *(u32x4*)(GG + go) = *(const LAS u32x4*)(SLOTP(13) + row * LD + 8 * ch);
        }
        __syncthreads();
    }
}

constexpr int RW2_D = 8;
DEV void rw2_phase(LAS unsigned char* lds, const bf16_t* PT, bf16_t* GG, int wave, int lane) {
    const int tid = threadIdx.x;
    if (blockIdx.x >= BATCH * NH * 4) return;
    const int bh = blockIdx.x >> 2, vs = blockIdx.x & 3;
    const size_t ubase = (size_t)bh * 128;
    LAS bf16_t* Pl[2] = { SLOTP(0), SLOTP(1) };
    LAS bf16_t* Gl[2] = { SLOTP(2), SLOTP(3) };
    const bf16_t* psrc = PT + ubase * 4096 + tid * 8;
    const bf16_t* gsrc = GG + ubase * 4096 + (size_t)vs * 16 * 64 + tid * 8;
    const int prow = tid >> 3, pch = tid & 7;
    u32x4 pr[RW2_D], qr[RW2_D];
#pragma unroll
    for (int i = 0; i < RW2_D; ++i) { pr[i] = *(const u32x4*)(psrc + (size_t)i * 4096); qr[i] = (tid < 128) ? *(const u32x4*)(gsrc + (size_t)i * 4096) : (u32x4){0u, 0u, 0u, 0u}; }
    const int fr = lane & 15, g = lane >> 4;
    f32x4 acc[4];
#pragma unroll
    for (int m = 0; m < 4; ++m) acc[m] = (f32x4){0.f, 0.f, 0.f, 0.f};
#pragma unroll 1
    for (int c0 = 0; c0 < 128; c0 += RW2_D) {
#pragma unroll
        for (int i = 0; i < RW2_D; ++i) {
            const int c = c0 + i, sl = i & 1;
            *(LAS u32x4*)(Pl[sl] + prow * LD + 8 * pch) = pr[i];
            if (tid < 128) *(LAS u32x4*)(Gl[sl] + prow * LD + 8 * pch) = qr[i];
            if (c + RW2_D < 128) { pr[i] = *(const u32x4*)(psrc + (size_t)(c + RW2_D) * 4096); if (tid < 128) qr[i] = *(const u32x4*)(gsrc + (size_t)(c + RW2_D) * 4096); }
            __syncthreads();
            if (wave == 0) {
                bf16_t* sdst = GG + (ubase + c) * 4096 + (size_t)(vs * 16 + fr) * 64;
                u32x2 sb[4];
#pragma unroll
                for (int m = 0; m < 4; ++m) { sb[m].x = pk2(acc[m][0], acc[m][1]); sb[m].y = pk2(acc[m][2], acc[m][3]); *(u32x2*)(sdst + 16 * m + 4 * g) = sb[m]; }
                u32x4 b0, b1; b0.x = sb[0].x; b0.y = sb[0].y; b0.z = sb[1].x; b0.w = sb[1].y; b1.x = sb[2].x; b1.y = sb[2].y; b1.z = sb[3].x; b1.w = sb[3].y;
                const bf16x8_t bf0 = __builtin_bit_cast(bf16x8_t, b0), bf1 = __builtin_bit_cast(bf16x8_t, b1);
#pragma unroll
                for (int m = 0; m < 4; ++m) {
                    const u32x2 gw = *(const LAS u32x2*)(Gl[sl] + fr * LD + 16 * m + 4 * g);
                    f32x4 cin; cin[0] = __builtin_bit_cast(float, gw.x << 16); cin[1] = __builtin_bit_cast(float, gw.x & 0xffff0000u); cin[2] = __builtin_bit_cast(float, gw.y << 16); cin[3] = __builtin_bit_cast(float, gw.y & 0xffff0000u);
                    const LAS bf16_t* prw = Pl[sl] + (16 * m + fr) * LD + 4 * g;
                    const u32x2 a00 = *(const LAS u32x2*)(prw), a01 = *(const LAS u32x2*)(prw + 16), a10 = *(const LAS u32x2*)(prw + 32), a11 = *(const LAS u32x2*)(prw + 48);
                    u32x4 af0, af1; af0.x = a00.x; af0.y = a00.y; af0.z = a01.x; af0.w = a01.y; af1.x = a10.x; af1.y = a10.y; af1.z = a11.x; af1.w = a11.y;
                    cin = __builtin_amdgcn_mfma_f32_16x16x32_bf16(__builtin_bit_cast(bf16x8_t, af0), bf0, cin, 0, 0, 0);
                    cin = __builtin_amdgcn_mfma_f32_16x16x32_bf16(__builtin_bit_cast(bf16x8_t, af1), bf1, cin, 0, 0, 0);
                    acc[m] = cin;
                }
            }
        }
    }
}

DEV void rw3_phase(LAS unsigned char* lds, const Args& a, const bf16_t* RH, const bf16_t* YH, const bf16_t* SS, const float* BON,
                   const bf16_t* Vb, const bf16_t* Gb, bf16_t* OG, int wave, int lane) {
    const int tid = threadIdx.x;
    const int mt = wave & 3, nh = wave >> 2, fr = lane & 15, g = lane >> 4;
    LAS float* YF = (LAS float*)(lds + 4 * SLOT);
    const float *lng = a.in[I_LNG], *lnb = a.in[I_LNB];
    for (int u = blockIdx.x; u < BATCH * NH * (SEQ / 64); u += gridDim.x) {
        const int c = u & 127, bh = u >> 7, h = bh & 15, b = bh >> 4;
        const size_t t0 = (size_t)b * SEQ + (size_t)c * 64;
        {
            const int row = tid >> 3, ch = tid & 7; const size_t go = (size_t)u * 4096 + tid * 8;
            *(LAS u32x4*)(SLOTP(0) + row * LD + 8 * ch) = *(const u32x4*)(RH + go);
            *(LAS u32x4*)(SLOTP(1) + row * LD + 8 * ch) = *(const u32x4*)(SS + go);
            *(LAS u32x4*)(SLOTP(2) + row * LD + 8 * ch) = *(const u32x4*)(YH + go);
        }
        __syncthreads();
        {
            f32x4 y[2]; ZERO2(y);
            mm64(SLOTP(0), SLOTP(1), y, wave, lane);
#pragma unroll
            for (int j = 0; j < 2; ++j)
#pragma unroll
                for (int r = 0; r < 4; ++r) { const int row = 16 * mt + 4 * g + r, cl = 32 * nh + 16 * j + fr;
                    YF[row * 64 + cl] = y[j][r] + bf2f(SLOTP(2)[row * LD + cl]); }
        }
        __syncthreads();
        {
            const int col = h * HD + lane;
            const float lg = lng[col], lb = lnb[col];
#pragma unroll
            for (int i = 0; i < 8; ++i) {
                const int tl = 8 * wave + i; const size_t t = t0 + tl;
                const float y = YF[tl * 64 + lane];
                const float mu = wave_sum(y) * (1.f / HD); const float dy = y - mu;
                const float var = wave_sum(dy * dy) * (1.f / HD);
                const float yn = dy * (1.f / sqrtf(var + LNX_EPS)) * lg + lb;
                const float bon = BON[t * NH + h] * bf2f(Vb[t * DM + col]);
                const float gt = bf2f(Gb[t * DM + col]);
                OG[t * DM + col] = (bf16_t)f2bf((yn + bon) * silu_f(gt));
            }
        }
        __syncthreads();
    }
}
typedef float f32x16 __attribute__((ext_vector_type(16)));
typedef short v4i16_t __attribute__((ext_vector_type(4)));
constexpr float MOBA_C2 = 0.125f * 1.4426950408889634f;
constexpr int MB_QL = 0, MB_KV = 32768, MB_OACC = 65536, MB_LACC = 131072, MB_LIST = 132096, MB_CNT = 140288, MB_SEL = 140416;
DEV int crow(int r, int hi) { return (r & 3) + 8 * (r >> 2) + 4 * hi; }


DEV void moba_tile32(LAS unsigned char* kvb, int kt, int keypos0, int tq, bool own, float slope2,
                     const bf16x8_t& qf0, const bf16x8_t& qf1, const bf16x8_t& qf2, const bf16x8_t& qf3, f32x16& O0, f32x16& O1, float& lsum, int lane) {
    const int r32 = lane & 31, hi = lane >> 5;
    f32x16 S;
#pragma unroll
    for (int r = 0; r < 16; ++r) S[r] = 0.f;
    {
        const LAS unsigned char* kp = kvb + hi * 1024 + (32 * kt + r32) * 16;
        S = __builtin_amdgcn_mfma_f32_32x32x16_bf16(*(const LAS bf16x8_t*)(kp), qf0, S, 0, 0, 0);
        S = __builtin_amdgcn_mfma_f32_32x32x16_bf16(*(const LAS bf16x8_t*)(kp + 2048), qf1, S, 0, 0, 0);
        S = __builtin_amdgcn_mfma_f32_32x32x16_bf16(*(const LAS bf16x8_t*)(kp + 4096), qf2, S, 0, 0, 0);
        S = __builtin_amdgcn_mfma_f32_32x32x16_bf16(*(const LAS bf16x8_t*)(kp + 6144), qf3, S, 0, 0, 0);
    }
    const int dbase = keypos0 + 4 * hi - tq;
    float p[16]; float ls = 0.f;
#pragma unroll
    for (int r = 0; r < 16; ++r) {
        const int dist = dbase + (r & 3) + 8 * (r >> 2);
        float pv = __builtin_amdgcn_exp2f(S[r] + slope2 * (float)dist);
        if (own && dist > 0) pv = 0.f;
        p[r] = pv; ls += pv;
    }
    lsum += ls;
    u32x4 w0, w1;
    w0.x = pk2(p[0], p[1]); w0.y = pk2(p[2], p[3]); w0.z = pk2(p[4], p[5]); w0.w = pk2(p[6], p[7]);
    w1.x = pk2(p[8], p[9]); w1.y = pk2(p[10], p[11]); w1.z = pk2(p[12], p[13]); w1.w = pk2(p[14], p[15]);
    const bf16x8_t pa0 = __builtin_bit_cast(bf16x8_t, w0), pa1 = __builtin_bit_cast(bf16x8_t, w1);
    const int i16 = lane & 15;
    const LAS unsigned char* vp = kvb + 8192 + (32 * kt + 4 * hi + (i16 >> 2)) * 64 + (((lane >> 4) & 1) * 16 + 4 * (i16 & 3)) * 2;
#pragma unroll
    for (int d0 = 0; d0 < 2; ++d0) {
#pragma unroll
        for (int s2 = 0; s2 < 2; ++s2) {
            const v4i16_t lo = __builtin_amdgcn_ds_read_tr16_b64_v4i16((LAS v4i16_t*)(vp + d0 * 4096 + (16 * s2) * 64));
            const v4i16_t hv = __builtin_amdgcn_ds_read_tr16_b64_v4i16((LAS v4i16_t*)(vp + d0 * 4096 + (16 * s2 + 8) * 64));
            const bf16x8_t vf = (bf16x8_t){lo[0], lo[1], lo[2], lo[3], hv[0], hv[1], hv[2], hv[3]};
            if (d0 == 0) O0 = __builtin_amdgcn_mfma_f32_32x32x16_bf16(s2 ? pa1 : pa0, vf, O0, 0, 0, 0);
            else         O1 = __builtin_amdgcn_mfma_f32_32x32x16_bf16(s2 ? pa1 : pa0, vf, O1, 0, 0, 0);
        }
    }
}
DEV void moba_flush(LAS float* OACC, LAS float* LACC, const LAS unsigned char* LIST, int jb, int tile, int cnt, bool own,
                    const f32x16& O0, const f32x16& O1, float lsum, int lane) {
    const int r32 = lane & 31, hi = lane >> 5;
#pragma unroll
    for (int r = 0; r < 16; ++r) {
        const int slot = 32 * tile + crow(r, hi);
        if (slot < cnt) {
            const int qrow = own ? slot : (int)LIST[jb * 256 + slot];
            LAS float* op = OACC + qrow * 64 + r32;
            if (own) { op[0] = O0[r]; op[32] = O1[r]; } else { op[0] += O0[r]; op[32] += O1[r]; }
        }
    }
    const float ltot = lsum + __shfl_xor(lsum, 32);
    if (hi == 0) { const int slot = 32 * tile + r32;
        if (slot < cnt) { const int q = own ? slot : (int)LIST[jb * 256 + slot]; if (own) LACC[q] = ltot; else LACC[q] += ltot; } }
}

struct MobaTile { u32x4 k, v; };
DEV void moba_ld_tile(MobaTile& T, const bf16_t* Kh, const bf16_t* Vh, int blk, int s, int tid) {
    const size_t off = ((size_t)blk * MBLK + 64 * s + (tid >> 3)) * DM + 8 * (tid & 7);
    T.k = *(const u32x4*)(Kh + off); T.v = *(const u32x4*)(Vh + off);
}
DEV void moba_st_tile(LAS unsigned char* buf, const MobaTile& T, int tid) {
    const int key = tid >> 3, ch = tid & 7;
    *(LAS u32x4*)(buf + ch * 1024 + key * 16) = T.k;
    *(LAS u32x4*)(buf + 8192 + (ch >> 2) * 4096 + key * 64 + (ch & 3) * 16) = T.v;
}

DEV void moba_phase(LAS unsigned char* lds, const bf16_t* Qb, const bf16_t* Kb, const bf16_t* Vb, const bf16_t* Gb, const bf16_t* KMH, const bf16_t* KML,
                    bf16_t* OG, int wave, int lane) {
    const int tid = threadIdx.x, r32 = lane & 31, hi = lane >> 5;
    const int G = gridDim.x, bx = blockIdx.x;
    LAS float* OACC = (LAS float*)(lds + MB_OACC); LAS float* LACC = (LAS float*)(lds + MB_LACC);
    LAS unsigned char* LIST = lds + MB_LIST; LAS int* CNT = (LAS int*)(lds + MB_CNT); LAS unsigned char* SEL = lds + MB_SEL;
    const int nunits = BATCH * NH * NBLK;
    for (int it = 0;; ++it) {
        int bh, qb;
        if (G == 256) { if (it >= 4) break; const int vcu = (bx & 7) * 32 + (bx >> 3), s8 = vcu & 7; bh = vcu >> 3; qb = (it == 0) ? s8 : (it == 1) ? 15 - s8 : (it == 2) ? 16 + s8 : 31 - s8; }
        else { const int u = bx + it * G; if (u >= nunits) break; bh = u / NBLK; qb = u % NBLK; }
        const int b = bh / NH, h = bh % NH;
        const float slope2 = exp2f(-0.5f * (float)(h + 1)) * 1.4426950408889634f;
        const bf16_t* Qh = Qb + (size_t)b * SEQ * DM + h * HD; const bf16_t* Kh = Kb + (size_t)b * SEQ * DM + h * HD; const bf16_t* Vh = Vb + (size_t)b * SEQ * DM + h * HD;
        MobaTile TA, TB;
        moba_ld_tile(TA, Kh, Vh, qb, 0, tid);
        moba_ld_tile(TB, Kh, Vh, qb, 1, tid);
#pragma unroll
        for (int i = 0; i < 4; ++i) { const int idx = tid + 512 * i, q = idx >> 3, ch = idx & 7;
            *(LAS u32x4*)(lds + MB_QL + ch * 4096 + q * 16) = *(const u32x4*)(Qh + ((size_t)qb * MBLK + q) * DM + 8 * ch); }
        __syncthreads();
        {
            f32x16 sg;
#pragma unroll
            for (int r = 0; r < 16; ++r) sg[r] = 0.f;
#pragma unroll
            for (int ks = 0; ks < 4; ++ks) {
                const bf16x8_t qf = *(const LAS bf16x8_t*)(lds + MB_QL + (2 * ks + hi) * 4096 + (32 * wave + r32) * 16);
                const size_t ko = ((size_t)bh * NBLK + r32) * HD + 16 * ks + 8 * hi;
                const bf16x8_t kh = *(const bf16x8_t*)(KMH + ko), kl = *(const bf16x8_t*)(KML + ko);
                sg = __builtin_amdgcn_mfma_f32_32x32x16_bf16(kh, qf, sg, 0, 0, 0);
                sg = __builtin_amdgcn_mfma_f32_32x32x16_bf16(kl, qf, sg, 0, 0, 0);
            }
            float v1 = -INFINITY, v2 = -INFINITY, v3 = -INFINITY; int i1 = 255, i2 = 255, i3 = 255;
#define TOP3_INS(x, ix) do { const float x_ = (x); const int ix_ = (ix); \
            if (x_ > v1) { v3 = v2; i3 = i2; v2 = v1; i2 = i1; v1 = x_; i1 = ix_; } \
            else if (x_ > v2) { v3 = v2; i3 = i2; v2 = x_; i2 = ix_; } \
            else if (x_ > v3) { v3 = x_; i3 = ix_; } } while (0)
#pragma unroll
            for (int r = 0; r < 16; ++r) { const int blk = crow(r, hi); const float x = (blk < qb) ? sg[r] : -INFINITY; TOP3_INS(x, blk); }
            const float o1 = __shfl_xor(v1, 32), o2 = __shfl_xor(v2, 32), o3 = __shfl_xor(v3, 32);
            const int j1 = __shfl_xor(i1, 32), j2 = __shfl_xor(i2, 32), j3 = __shfl_xor(i3, 32);
            TOP3_INS(o1, j1); TOP3_INS(o2, j2); TOP3_INS(o3, j3);
#undef TOP3_INS
            if (hi == 0) { const unsigned w = (unsigned)(v1 > -INFINITY ? i1 : 255) | ((unsigned)(v2 > -INFINITY ? i2 : 255) << 8) | ((unsigned)(v3 > -INFINITY ? i3 : 255) << 16) | 0xff000000u;
                *(LAS unsigned*)(SEL + (32 * wave + r32) * 4) = w; }
        }
        __syncthreads();
#pragma unroll 1
        for (int j = wave; j < NBLK; j += 8) {
            int off = 0;
            if (j < qb) {
#pragma unroll 1
                for (int p = 0; p < 4; ++p) {
                    const int q = 64 * p + lane; const unsigned s = *(const LAS unsigned*)(SEL + q * 4);
                    const bool match = ((s & 0xff) == (unsigned)j) || (((s >> 8) & 0xff) == (unsigned)j) || (((s >> 16) & 0xff) == (unsigned)j);
                    const unsigned long long bal = __ballot(match);
                    const int pre = __builtin_amdgcn_mbcnt_hi((unsigned)(bal >> 32), __builtin_amdgcn_mbcnt_lo((unsigned)bal, 0u));
                    if (match) LIST[j * 256 + off + pre] = (unsigned char)q;
                    off += __builtin_popcountll(bal);
                }
            }
            if (lane == 0) CNT[j] = off;
        }
        moba_st_tile(lds + MB_KV, TA, tid);
        __syncthreads();
        const int NS = 4 * (qb + 1);
        f32x16 O0, O1; float lsum = 0.f; bf16x8_t qf0, qf1, qf2, qf3;
        int tile = 0, cnt = 0, jb = 0, tq = 0, qi = 0; bool active = false, mode2 = false, own = true;
#pragma unroll
        for (int r = 0; r < 16; ++r) { O0[r] = 0.f; O1[r] = 0.f; }
        qf0 = qf1 = qf2 = qf3 = (bf16x8_t){0, 0, 0, 0, 0, 0, 0, 0};
#define MOBA_STEP(ts, TW, TL) do { \
        const int ts_ = (ts), bi_ = ts_ >> 2, s_ = ts_ & 3; \
        { const int t2 = ts_ + 2; if (t2 < NS) { const int b2 = t2 >> 2; moba_ld_tile(TL, Kh, Vh, b2 == 0 ? qb : b2 - 1, t2 & 3, tid); } } \
        if (s_ == 0) { \
            own = (bi_ == 0); jb = own ? qb : bi_ - 1; cnt = own ? 256 : __builtin_amdgcn_readfirstlane(CNT[jb]); \
            const int n_ = (cnt + 31) >> 5; mode2 = (!own) && (n_ <= 4); tile = mode2 ? (wave >> 1) : wave; active = tile < n_; \
            if (active) { int slot = 32 * tile + r32; if (slot > cnt - 1) slot = cnt - 1; qi = own ? slot : (int)LIST[jb * 256 + slot]; tq = qb * MBLK + qi; \
                qf0 = *(const LAS bf16x8_t*)(lds + MB_QL + (0 + hi) * 4096 + qi * 16); qf1 = *(const LAS bf16x8_t*)(lds + MB_QL + (2 + hi) * 4096 + qi * 16); \
                qf2 = *(const LAS bf16x8_t*)(lds + MB_QL + (4 + hi) * 4096 + qi * 16); qf3 = *(const LAS bf16x8_t*)(lds + MB_QL + (6 + hi) * 4096 + qi * 16); \
                _Pragma("unroll") for (int r = 0; r < 16; ++r) { O0[r] = 0.f; O1[r] = 0.f; } lsum = 0.f; } } \
        if (active) { \
            LAS unsigned char* kvb = lds + MB_KV + (ts_ & 1) * 16384; \
            _Pragma("unroll") for (int kt = 0; kt < 2; ++kt) { \
                const bool dok = mode2 ? (kt == (wave & 1)) : (!own || (64 * s_ + 32 * kt <= 32 * tile + 31)); \
                if (dok) moba_tile32(kvb, kt, jb * MBLK + 64 * s_ + 32 * kt, tq, own, slope2, qf0, qf1, qf2, qf3, O0, O1, lsum, lane); } \
            if (s_ == 3 && !(mode2 && (wave & 1))) moba_flush(OACC, LACC, LIST, jb, tile, cnt, own, O0, O1, lsum, lane); } \
        if (ts_ + 1 < NS) moba_st_tile(lds + MB_KV + ((ts_ + 1) & 1) * 16384, TW, tid); \
        __syncthreads(); \
        if (active && s_ == 3 && mode2 && (wave & 1)) moba_flush(OACC, LACC, LIST, jb, tile, cnt, own, O0, O1, lsum, lane); \
    } while (0)
#pragma unroll 1
        for (int ts = 0; ts < NS; ts += 2) { MOBA_STEP(ts, TB, TA); MOBA_STEP(ts + 1, TA, TB); }
#undef MOBA_STEP
        __syncthreads();
        {
            const int q = tid >> 1, half = tid & 1; const float linv = 1.f / LACC[q];
            const size_t t = (size_t)b * SEQ + (size_t)qb * MBLK + q; const int col = h * HD + 32 * half;
#pragma unroll
            for (int c4 = 0; c4 < 4; ++c4) {
                const f32x4 oa = *(const LAS f32x4*)(OACC + q * 64 + 32 * half + 8 * c4), ob = *(const LAS f32x4*)(OACC + q * 64 + 32 * half + 8 * c4 + 4);
                float gv[8]; unpack8(*(const u32x4*)(Gb + t * DM + col + 8 * c4), gv);
                u32x4 w; w.x = pk2(oa.x * linv * silu_f(gv[0]), oa.y * linv * silu_f(gv[1])); w.y = pk2(oa.z * linv * silu_f(gv[2]), oa.w * linv * silu_f(gv[3]));
                w.z = pk2(ob.x * linv * silu_f(gv[4]), ob.y * linv * silu_f(gv[5])); w.w = pk2(ob.z * linv * silu_f(gv[6]), ob.w * linv * silu_f(gv[7]));
                *(u32x4*)(OG + t * DM + col + 8 * c4) = w;
            }
        }
        __syncthreads();
    }
}
__global__ void __launch_bounds__(NTHREADS, 2) fwd_kernel(Args args) {
    extern __shared__ __attribute__((aligned(16))) unsigned char lds_raw[];
    LAS unsigned char* lds = (LAS unsigned char*)lds_raw;
    const int tid = threadIdx.x, lane = tid & 63, wave = __builtin_amdgcn_readfirstlane(tid >> 6);
    const int G = gridDim.x; const int gw = blockIdx.x * NWAVES + wave, ngw = G * NWAVES;
    unsigned char* ws = args.ws;
    unsigned* ctl = (unsigned*)(ws + WS_CTL);
    volatile LAS unsigned* MISC = (volatile LAS unsigned*)(lds + LDS_BYTES - 64);
    if (tid < 16) MISC[tid] = 0u;
    __syncthreads();
    XcdBarrier bar; bar.bar = ctl + CW_BAR; bar.x = 0; bar.st = nullptr;
    const int lo = args.ph_lo, hi = args.ph_hi;
    if (hi - lo > 1) bar = xcd_barrier_post(ctl + CW_BAR, MISC + 8);
#define IN(k) (lo <= (k) && (k) < hi)
#define SEAM(k) do { if (IN(k) && IN((k) + 1)) xcd_barrier(bar); } while (0)

    const float* x = args.in[I_X]; float* out = args.out;
    bf16_t* H0 = (bf16_t*)(ws + WS_H0); bf16_t* L0 = (bf16_t*)(ws + WS_L0); bf16_t* H1 = (bf16_t*)(ws + WS_H1);
    bf16_t* Qb = (bf16_t*)(ws + WS_Q); bf16_t* Kb = (bf16_t*)(ws + WS_K); bf16_t* Vb = (bf16_t*)(ws + WS_V);
    bf16_t* Gb = (bf16_t*)(ws + WS_G); bf16_t* OG = (bf16_t*)(ws + WS_OG);
    bf16_t* XS0 = (bf16_t*)out; bf16_t* XS1 = (bf16_t*)out + (size_t)M * DM; bf16_t* XS2 = (bf16_t*)(ws + WS_XS2); bf16_t* XS3 = (bf16_t*)(ws + WS_XS3);
    bf16_t* KMH = (bf16_t*)(ws + WS_KM); bf16_t* KML = (bf16_t*)(ws + WS_KM + 128 * 1024); bf16_t* LW = (bf16_t*)(ws + WS_LW); bf16_t* LA = (bf16_t*)(ws + WS_LA); float* BON = (float*)(ws + WS_BON);
    bf16_t* RH = (bf16_t*)out; bf16_t* YH = (bf16_t*)out + (size_t)M * DM; bf16_t* PT = (bf16_t*)(ws + WS_PT); bf16_t* GG = (bf16_t*)(ws + WS_GG);
    const pg8::bf16_t* win0 = (const pg8::bf16_t*)(ws + WS_WIN0); const pg8::bf16_t* wout0 = (const pg8::bf16_t*)(ws + WS_WOUT0);
    const pg8::bf16_t* win1 = (const pg8::bf16_t*)(ws + WS_WIN1); const pg8::bf16_t* wout1 = (const pg8::bf16_t*)(ws + WS_WOUT1);

    if (IN(0)) { p0_prologue(lds, args, ws, gw, ngw, wave, lane); } SEAM(0);
    if (IN(1)) {
        pg8::Gemm g{H0, win0, M, 4 * DM, DM, nullptr, nullptr, nullptr, 0}; pg8::StaticOrder S; S.init(M, 4 * DM, G, (int)blockIdx.x);
        pg8::EpiBf16<0> E{Qb, DM, nullptr, DM, (size_t)M * DM, MOBA_C2};
        pg8::gemm_phase<pg8::EpiBf16<0>, pg8::StaticOrder, true, true>(lds, g, S, E);
    } SEAM(1);
    if (IN(2)) { kmean_phase(Kb, KMH, KML, gw, ngw, lane); } SEAM(2);
    if (IN(3)) { moba_phase(lds, Qb, Kb, Vb, Gb, KMH, KML, OG, wave, lane); } SEAM(3);
    if (IN(4)) {
        pg8::Gemm g{OG, wout0, M, DM, DM, nullptr, nullptr, nullptr, 0}; pg8::StaticOrder S; S.init(M, DM, G, (int)blockIdx.x);
        pg8::EpiRes E{x, nullptr, L0, out};
        pg8::gemm_phase<pg8::EpiRes, pg8::StaticOrder, false, true>(lds, g, S, E);
    } SEAM(4);
    if (IN(5)) { rms_rows<true>(out, args.in[I_RNG], H1, nullptr, gw, ngw, lane); } SEAM(5);
    if (IN(6)) { xs_lora_phase(H1, args.in[I_RMIX], XS0, XS1, XS2, XS3, (const bf16_t*)(ws + WS_W1T), (const bf16_t*)(ws + WS_A1T), LW, LA, wave, lane); } SEAM(6);
    if (IN(7)) {
        pg8::Gemm g{XS0, win1, M, 4 * DM, DM, XS1, XS2, XS3, 1}; pg8::StaticOrder S; S.init(M, 4 * DM, G, (int)blockIdx.x);
        pg8::EpiBf16<0> E{Qb, DM, nullptr, DM, (size_t)M * DM, 1.f};
        pg8::gemm_phase<pg8::EpiBf16<0>, pg8::StaticOrder, true, true>(lds, g, S, E);
    } SEAM(7);
    if (IN(8)) { rw1_phase(lds, args, Qb, Kb, Vb, LW, LA, (const bf16_t*)(ws + WS_W2T), (const bf16_t*)(ws + WS_A2T), RH, YH, PT, GG, BON, wave, lane); } SEAM(8);
    if (IN(9)) { rw2_phase(lds, PT, GG, wave, lane); } SEAM(9);
    if (IN(10)) { rw3_phase(lds, args, RH, YH, GG, BON, Vb, Gb, OG, wave, lane); } SEAM(10);
    if (IN(11)) {
        pg8::Gemm g{OG, wout1, M, DM, DM, nullptr, nullptr, nullptr, 0}; pg8::StaticOrder S; S.init(M, DM, G, (int)blockIdx.x);
        pg8::EpiRes E{x, L0, nullptr, out};
        pg8::gemm_phase<pg8::EpiRes, pg8::StaticOrder, false, true>(lds, g, S, E);
    } SEAM(11);
    if (IN(12)) { rms_rows<false>(out, args.in[I_FNG], nullptr, out, gw, ngw, lane); }
#undef IN
#undef SEAM
}

extern "C" void kernel_launch(void* const* d_in, const int* in_sizes, int n_in, void* d_out, int out_size, void* d_ws, size_t ws_size, hipStream_t stream) {
    static int grid = 0;
    if (grid == 0) {
        if (n_in != 20 || in_sizes[0] != M * DM || out_size != M * DM || ws_size < WS_END) { fprintf(stderr, "kernel_launch: unexpected shapes (n_in %d, in0 %d, out %d, ws %zu)\n", n_in, n_in > 0 ? in_sizes[0] : -1, out_size, ws_size); grid = -1; return; }
        int dev = 0, cus = 0, per_cu = 0;
        if (hipGetDevice(&dev) != hipSuccess || hipDeviceGetAttribute(&cus, hipDeviceAttributeMultiprocessorCount, dev) != hipSuccess) { grid = -1; return; }
        if (hipFuncSetAttribute((const void*)fwd_kernel, hipFuncAttributeMaxDynamicSharedMemorySize, LDS_BYTES) != hipSuccess) { fprintf(stderr, "kernel_launch: hipFuncSetAttribute failed\n"); grid = -1; return; }
        if (hipOccupancyMaxActiveBlocksPerMultiprocessor(&per_cu, (const void*)fwd_kernel, NTHREADS, LDS_BYTES) != hipSuccess || per_cu < 1) { fprintf(stderr, "kernel_launch: occupancy query says %d blocks per CU\n", per_cu); per_cu = 1; }
        (void)hipGetLastError();
        grid = cus;
    }
    if (grid < 0) return;
    (void)hipMemsetAsync((char*)d_ws + WS_CTL, 0, CTL_ZERO_BYTES, stream);
    Args a{};
    for (int i = 0; i < 20; ++i) a.in[i] = (const float*)d_in[i];
    a.out = (float*)d_out; a.ws = (unsigned char*)d_ws;
    if (MK_ONE_LAUNCH) {
        a.ph_lo = 0; a.ph_hi = N_PHASES;
        hipLaunchKernelGGL(fwd_kernel, dim3(grid), dim3(NTHREADS), LDS_BYTES, stream, a);
    } else {
        for (int p = 0; p < N_PHASES; ++p) { a.ph_lo = p; a.ph_hi = p + 1; hipLaunchKernelGGL(fwd_kernel, dim3(grid), dim3(NTHREADS), LDS_BYTES, stream, a); }
    }
}
```
